# Optimizing an MI355X kernel written in HIP

```python
import math
import jax, jax.numpy as jnp
from jax import lax
import numpy as np

D_MODEL = 1024
BATCH = 4
SEQ = 8192
DEPTH = 2

CONV_WIDTH = 31
HEAD_DIM = 64
N_Q_HEADS = D_MODEL // HEAD_DIM
N_KV_HEADS = 4
GROUP = N_Q_HEADS // N_KV_HEADS
WINDOW = 128
BLOCK = 128
NUM_BUCKETS = 32
MAX_DISTANCE = 128
D_FF = ((8 * D_MODEL // 3 + 255) // 256) * 256
EPS = 1e-6

kernel_name = "hybrid_conv_swa_sink_t5_swiglu"


def rms_norm(x, g):
    xf = x.astype(jnp.float32)
    y = xf * lax.rsqrt(jnp.mean(xf * xf, axis=-1, keepdims=True) + EPS)
    return (y * g.astype(jnp.float32)).astype(x.dtype)


def layer_norm(x, g, b):
    xf = x.astype(jnp.float32)
    mu = jnp.mean(xf, axis=-1, keepdims=True)
    xc = xf - mu
    var = jnp.mean(xc * xc, axis=-1, keepdims=True)
    y = xc * lax.rsqrt(var + EPS) * g.astype(jnp.float32) + b.astype(jnp.float32)
    return y.astype(x.dtype)


def conformer_conv(x, w_in, b_in, dw_w, dw_b, ln_g, ln_b, w_out, b_out):
    u = x @ w_in + b_in
    val, gate = jnp.split(u, 2, axis=-1)
    u = val * jax.nn.sigmoid(gate)
    u = lax.conv_general_dilated(
        u, dw_w[:, None, :].astype(u.dtype), window_strides=(1,),
        padding=[(CONV_WIDTH - 1, 0)],
        dimension_numbers=("NWC", "WIO", "NWC"),
        feature_group_count=D_MODEL) + dw_b
    u = jax.nn.silu(layer_norm(u, ln_g, ln_b))
    return u @ w_out + b_out


def t5_causal_bucket(dist):
    dist = jnp.maximum(dist, 0)
    max_exact = NUM_BUCKETS // 2
    large = max_exact + (
        jnp.log(jnp.maximum(dist, 1).astype(jnp.float32) / max_exact)
        / math.log(MAX_DISTANCE / max_exact) * (NUM_BUCKETS - max_exact)
    ).astype(jnp.int32)
    large = jnp.minimum(large, NUM_BUCKETS - 1)
    return jnp.where(dist < max_exact, dist, large)


def swa_sink_attention(x, w_qkv, b_qkv, w_o, b_o, sinks, rel_bias):
    B, S, _ = x.shape
    nb = S // BLOCK
    qkv = x @ w_qkv + b_qkv
    q, k, v = jnp.split(qkv, [N_Q_HEADS * HEAD_DIM, (N_Q_HEADS + N_KV_HEADS) * HEAD_DIM], axis=-1)
    q = q.reshape(B, nb, BLOCK, N_KV_HEADS, GROUP, HEAD_DIM)
    k = k.reshape(B, nb, BLOCK, N_KV_HEADS, HEAD_DIM)
    v = v.reshape(B, nb, BLOCK, N_KV_HEADS, HEAD_DIM)
    k_prev = jnp.concatenate([jnp.zeros_like(k[:, :1]), k[:, :-1]], axis=1)
    v_prev = jnp.concatenate([jnp.zeros_like(v[:, :1]), v[:, :-1]], axis=1)
    kb = jnp.concatenate([k_prev, k], axis=2)
    vb = jnp.concatenate([v_prev, v], axis=2)

    scale = HEAD_DIM ** -0.5
    logits = jnp.einsum("bnqkgd,bnskd->bnkgqs", q, kb,
                        preferred_element_type=jnp.float32) * scale

    q_loc = jnp.arange(BLOCK, dtype=jnp.int32)[:, None] + BLOCK
    s_loc = jnp.arange(2 * BLOCK, dtype=jnp.int32)[None, :]
    dist = q_loc - s_loc
    band = (dist >= 0) & (dist < WINDOW)
    bias = rel_bias.astype(jnp.float32)[t5_causal_bucket(dist)]
    bias = jnp.transpose(bias, (2, 0, 1)).reshape(N_KV_HEADS, GROUP, BLOCK, 2 * BLOCK)
    blk = jnp.arange(nb, dtype=jnp.int32)[:, None, None]
    valid = band[None] & ((blk * BLOCK - BLOCK + s_loc[None]) >= 0)

    logits = jnp.where(valid[None, :, None, None], logits + bias, -jnp.inf)
    sink = sinks.astype(jnp.float32).reshape(N_KV_HEADS, GROUP)[None, None, :, :, None, None]
    m = jnp.maximum(jnp.max(logits, axis=-1, keepdims=True), sink)
    p = jnp.exp(logits - m)
    denom = jnp.sum(p, axis=-1, keepdims=True) + jnp.exp(sink - m)
    p = (p / denom).astype(vb.dtype)
    out = jnp.einsum("bnkgqs,bnskd->bnqkgd", p, vb).reshape(B, S, N_Q_HEADS * HEAD_DIM)
    return out @ w_o + b_o


def swiglu_ffn(x, w_gate_up, w_down):
    g, u = jnp.split(x @ w_gate_up, 2, axis=-1)
    return (jax.nn.silu(g) * u) @ w_down


def setup_inputs(seed: int = 0) -> dict:
    key = jax.random.key(seed)
    keys = iter(jax.random.split(key, 64))
    n_conv = (DEPTH + 1) // 2
    n_attn = DEPTH // 2
    f32 = jnp.float32

    def w(shape, fan_in):
        return jax.random.normal(next(keys), shape, f32) * fan_in ** -0.5

    def gain(shape):
        return 1.0 + 0.05 * jax.random.normal(next(keys), shape, f32)

    def small(shape, s=0.02):
        return s * jax.random.normal(next(keys), shape, f32)

    qkv_w = (N_Q_HEADS + 2 * N_KV_HEADS) * HEAD_DIM
    return {
        "x": jax.random.normal(next(keys), (BATCH, SEQ, D_MODEL), f32),
        "mix_pre_g": gain((DEPTH, D_MODEL)),
        "mix_post_g": gain((DEPTH, D_MODEL)),
        "ffn_pre_g": gain((DEPTH, D_MODEL)),
        "ffn_post_g": gain((DEPTH, D_MODEL)),
        "conv_w_in": w((n_conv, D_MODEL, 2 * D_MODEL), D_MODEL),
        "conv_b_in": small((n_conv, 2 * D_MODEL)),
        "conv_dw_w": w((n_conv, CONV_WIDTH, D_MODEL), CONV_WIDTH),
        "conv_dw_b": small((n_conv, D_MODEL)),
        "conv_ln_g": gain((n_conv, D_MODEL)),
        "conv_ln_b": small((n_conv, D_MODEL)),
        "conv_w_out": w((n_conv, D_MODEL, D_MODEL), D_MODEL),
        "conv_b_out": small((n_conv, D_MODEL)),
        "attn_w_qkv": w((n_attn, D_MODEL, qkv_w), D_MODEL),
        "attn_b_qkv": small((n_attn, qkv_w)),
        "attn_w_o": w((n_attn, N_Q_HEADS * HEAD_DIM, D_MODEL), N_Q_HEADS * HEAD_DIM),
        "attn_b_o": small((n_attn, D_MODEL)),
        "attn_sinks": 0.5 * jax.random.normal(next(keys), (n_attn, N_Q_HEADS), f32),
        "rel_bias": 0.1 * jax.random.normal(next(keys), (NUM_BUCKETS, N_Q_HEADS), f32),
        "ffn_w_gate_up": w((DEPTH, D_MODEL, 2 * D_FF), D_MODEL),
        "ffn_w_down": w((DEPTH, D_FF, D_MODEL), D_FF),
    }


def reference(x, mix_pre_g, mix_post_g, ffn_pre_g, ffn_post_g,
              conv_w_in, conv_b_in, conv_dw_w, conv_dw_b, conv_ln_g, conv_ln_b,
              conv_w_out, conv_b_out,
              attn_w_qkv, attn_b_qkv, attn_w_o, attn_b_o, attn_sinks, rel_bias,
              ffn_w_gate_up, ffn_w_down):
    h = x
    for i in range(DEPTH):
        j = i // 2
        u = rms_norm(h, mix_pre_g[i])
        if i % 2 == 0:
            u = conformer_conv(u, conv_w_in[j], conv_b_in[j], conv_dw_w[j], conv_dw_b[j],
                               conv_ln_g[j], conv_ln_b[j], conv_w_out[j], conv_b_out[j])
        else:
            u = swa_sink_attention(u, attn_w_qkv[j], attn_b_qkv[j], attn_w_o[j], attn_b_o[j],
                                   attn_sinks[j], rel_bias)
        h = h + rms_norm(u, mix_post_g[i])
        f = swiglu_ffn(rms_norm(h, ffn_pre_g[i]), ffn_w_gate_up[i], ffn_w_down[i])
        h = h + rms_norm(f, ffn_post_g[i])
    return h
```

```cpp
#include <hip/hip_runtime.h>
#include <cstdio>
#include <cstdint>
__device__ __forceinline__ float sigmoid_f(float x) { return __builtin_amdgcn_rcpf(1.0f + __builtin_amdgcn_exp2f(-1.4426950408889634f * x)); }
namespace pg8 {
#define PG8_LAS __attribute__((address_space(3)))
typedef unsigned short bf16_t;
typedef short bf16x8 __attribute__((ext_vector_type(8)));
typedef float f32x4 __attribute__((ext_vector_type(4)));
typedef unsigned u32x4 __attribute__((ext_vector_type(4)));
constexpr int BM = 256, BK = 64, HALF = 128, HTB = HALF * BK * 2  , STAGE_BYTES = 8 * HTB, NXCD = 8, WGM = 8;

__host__ __device__ __forceinline__ int lds_byte(int r, int c) { const int st = (r >> 4) * 2 + (c >> 5), rr = r & 15, cc = c & 31, ob = rr * 64 + cc * 2; return st * 1024 + (ob ^ (((ob >> 9) & 1) << 5)); }
__host__ __device__ __forceinline__ void stage_rc(int b, int& R, int& C) { const int st = b / 1024, sb = b % 1024, swz = sb ^ (((sb >> 9) & 1) << 5); R = (st >> 1) * 16 + swz / 64; C = (st & 1) * 32 + (swz % 64) / 2; }
__host__ __device__ __forceinline__ int perm32(int rho) { const int n = rho >> 4, i = rho & 15; return 8 * (i >> 2) + 4 * n + (i & 3); }

struct Unit { int pm, pn; };
struct Gemm { const bf16_t* A; const bf16_t* Bt; int M, N, K; };

struct StaticOrder {
    int nM, nN, nwg, G, c;
    __host__ __device__ void init(int M, int N, int G_, int c_) { nM = M / BM; nN = N / BM; nwg = nM * nN; G = G_; c = c_; }
    __host__ __device__ bool next(int i, Unit& u) const {
        const long L = (long)i * G + c; if (L >= nwg) return false;
        int wgid = (int)L; { const int q = nwg / NXCD, r = nwg % NXCD, xcd = wgid % NXCD, off = wgid / NXCD; wgid = (xcd < r ? xcd * (q + 1) : r * (q + 1) + (xcd - r) * q) + off; }
        const int nig = WGM * nN, gid = wgid / nig, fm = gid * WGM, gsz = (nM - fm) < WGM ? (nM - fm) : WGM;
        u.pm = fm + ((wgid % nig) % gsz); u.pn = (wgid % nig) / gsz; return true;
    }
    __device__ __forceinline__ void a_ready(const Unit&) const {}
    __device__ __forceinline__ void done(const Unit&) const {}
};


__device__ __forceinline__ unsigned cvt_pk_bf16(float lo, float hi) { unsigned r; asm volatile("v_cvt_pk_bf16_f32 %0, %1, %2" : "=v"(r) : "v"(lo), "v"(hi)); return r; }

struct EpiF32 {
    static constexpr bool PERM = false, AFTER_DRAIN = false;
    float* C; int ldc; const float* bias;
    __device__ __forceinline__ void operator()(const f32x4 (&acc)[2][2][4][2], const Unit& u, int wr, int wc, int fr, int fq) const {
        const int row0 = u.pm * BM + wr * 64 + fr, col0 = u.pn * BM + wc * 32 + 4 * fq;
        f32x4 bv[2][2];
#pragma unroll
        for (int bj = 0; bj < 2; ++bj)
#pragma unroll
            for (int n = 0; n < 2; ++n) bv[bj][n] = bias ? *(const f32x4*)(bias + col0 + bj * HALF + n * 16) : (f32x4){0.f, 0.f, 0.f, 0.f};
#pragma unroll
        for (int ai = 0; ai < 2; ++ai)
#pragma unroll
            for (int m = 0; m < 4; ++m) { float* rowp = C + (size_t)(row0 + ai * HALF + m * 16) * ldc + col0;
#pragma unroll
                for (int bj = 0; bj < 2; ++bj)
#pragma unroll
                    for (int n = 0; n < 2; ++n) *(f32x4*)(rowp + bj * HALF + n * 16) = acc[ai][bj][m][n] + bv[bj][n]; }
    }
};
template <int ACT> struct EpiGate {
    static constexpr bool PERM = true, AFTER_DRAIN = false;
    bf16_t* O; int ldc; const float* bias; int half_cols;
    __device__ __forceinline__ void operator()(const f32x4 (&acc)[2][2][4][2], const Unit& u, int wr, int wc, int fr, int fq) const {
        const int row0 = u.pm * BM + wr * 64 + fr, oc0 = u.pn * HALF + wc * 32 + 8 * fq;
        f32x4 bv[2][2];
#pragma unroll
        for (int bj = 0; bj < 2; ++bj)
#pragma unroll
            for (int n = 0; n < 2; ++n) bv[bj][n] = bias ? *(const f32x4*)(bias + bj * half_cols + oc0 + 4 * n) : (f32x4){0.f, 0.f, 0.f, 0.f};
#pragma unroll
        for (int ai = 0; ai < 2; ++ai)
#pragma unroll
            for (int m = 0; m < 4; ++m) { bf16_t* rowp = O + (size_t)(row0 + ai * HALF + m * 16) * ldc + oc0;
                float r[8];
#pragma unroll
                for (int n = 0; n < 2; ++n) { const f32x4 a = acc[ai][0][m][n] + bv[0][n], b = acc[ai][1][m][n] + bv[1][n];
#pragma unroll
                    for (int j = 0; j < 4; ++j) r[4 * n + j] = (ACT == 0) ? a[j] * sigmoid_f(b[j]) : a[j] * sigmoid_f(a[j]) * b[j]; }
                u32x4 w; w.x = cvt_pk_bf16(r[0], r[1]); w.y = cvt_pk_bf16(r[2], r[3]); w.z = cvt_pk_bf16(r[4], r[5]); w.w = cvt_pk_bf16(r[6], r[7]);
                *(u32x4*)rowp = w; asm volatile("" ::: "memory"); }
    }
};
struct EpiQKV {
    static constexpr bool PERM = true, AFTER_DRAIN = false;
    bf16_t* Q; bf16_t* Kp; bf16_t* Vp; const float* bias; float qscale;
    __device__ __forceinline__ void operator()(const f32x4 (&acc)[2][2][4][2], const Unit& u, int wr, int wc, int fr, int fq) const {
        const int row0 = u.pm * BM + wr * 64 + fr; const int colt = u.pn * BM;
        bf16_t* base; int ldc, c0; float sc = 1.f;
        if (colt < 1024) { base = Q; ldc = 1024; c0 = colt; sc = qscale; } else if (colt < 1280) { base = Kp; ldc = 256; c0 = 0; } else { base = Vp; ldc = 256; c0 = 0; }
        const int col0 = c0 + wc * 32 + 8 * fq, bcol0 = colt + wc * 32 + 8 * fq;
        f32x4 bv[2][2];
#pragma unroll
        for (int bj = 0; bj < 2; ++bj)
#pragma unroll
            for (int n = 0; n < 2; ++n) bv[bj][n] = *(const f32x4*)(bias + bcol0 + bj * HALF + 4 * n);
#pragma unroll
        for (int ai = 0; ai < 2; ++ai)
#pragma unroll
            for (int m = 0; m < 4; ++m) { bf16_t* rowp = base + (size_t)(row0 + ai * HALF + m * 16) * ldc + col0;
#pragma unroll
                for (int bj = 0; bj < 2; ++bj) { const f32x4 v0 = (acc[ai][bj][m][0] + bv[bj][0]) * sc, v1 = (acc[ai][bj][m][1] + bv[bj][1]) * sc;
                    u32x4 w; w.x = cvt_pk_bf16(v0[0], v0[1]); w.y = cvt_pk_bf16(v0[2], v0[3]); w.z = cvt_pk_bf16(v1[0], v1[1]); w.w = cvt_pk_bf16(v1[2], v1[3]);
                    *(u32x4*)(rowp + bj * HALF) = w; } }
    }
};

template <class Epi, class Sched, bool ALIGN_EPI = false, bool SP2 = false>
__device__ __forceinline__ void gemm_phase(PG8_LAS unsigned char* lds, const Gemm g, const Sched& S, const Epi& E, const int tid) {
    const int wid = __builtin_amdgcn_readfirstlane(tid >> 6), lane = tid & 63, wr = wid >> 2, wc = wid & 3, fr = lane & 15, fq = lane >> 4;
    const int K = g.K, nt = K / BK;
    unsigned voffA[2], voffB[2];
#pragma unroll
    for (int i = 0; i < 2; ++i) { int R, C; stage_rc(tid * 16 + i * 8192, R, C); const int Rb = Epi::PERM ? ((R & ~31) + perm32(R & 31)) : R;
        voffA[i] = (unsigned)(R * K + C) * 2u; voffB[i] = (unsigned)(Rb * K + C) * 2u; }
    const size_t kstep = (size_t)(BK * 2);
    const size_t hstep = (size_t)HALF * K * 2;
    const size_t tstep = 2 * hstep;
    const unsigned ldsw = (unsigned)wid * 1024u;
    const int aoff = lds_byte(wr * 64 + fr, fq * 8), boff = lds_byte(wc * 32 + fr, fq * 8);
#define PG8_SA(b, h) (((b) * 2 + (h)) * HTB)
#define PG8_SB(b, h) ((4 + (b) * 2 + (h)) * HTB)
#define PG8_STAGE(bufoff, gbase, voff) do { _Pragma("unroll") for (int _i = 0; _i < 2; ++_i) \
        __builtin_amdgcn_global_load_lds((const unsigned*)((const char*)(gbase) + (voff)[_i]), (PG8_LAS unsigned*)(lds + (bufoff) + ldsw + _i * 8192), 16, 0, 0); } while (0)
#define PG8_LDA(dst, b, h) do { _Pragma("unroll") for (int m = 0; m < 4; ++m) _Pragma("unroll") for (int k = 0; k < 2; ++k) dst[m][k] = *(const PG8_LAS bf16x8*)(lds + PG8_SA(b, h) + aoff + m * 2048 + k * 1024); } while (0)
#define PG8_LDB(dst, b, h) do { _Pragma("unroll") for (int n = 0; n < 2; ++n) _Pragma("unroll") for (int k = 0; k < 2; ++k) dst[n][k] = *(const PG8_LAS bf16x8*)(lds + PG8_SB(b, h) + boff + n * 2048 + k * 1024); } while (0)
#define PG8_MMA(ai, bj, At, Bt) do { __builtin_amdgcn_s_setprio(1); _Pragma("unroll") for (int m = 0; m < 4; ++m) _Pragma("unroll") for (int n = 0; n < 2; ++n) _Pragma("unroll") for (int k = 0; k < 2; ++k) \
        acc[ai][bj][m][n] = __builtin_amdgcn_mfma_f32_16x16x32_bf16(Bt[n][k], At[m][k], acc[ai][bj][m][n], 0, 0, 0); __builtin_amdgcn_s_setprio(0); } while (0)
#define PG8_WAIT_V(n) asm volatile("s_waitcnt vmcnt(" #n ")" ::: "memory")
#define PG8_WAIT_L(n) asm volatile("s_waitcnt lgkmcnt(" #n ")" ::: "memory")
#define PG8_BAR __builtin_amdgcn_s_barrier()
#define PG8_SCHED __builtin_amdgcn_sched_barrier(0)
    Unit cur, nxt; int ui = 0;
    if (!S.next(0, cur)) return;
    f32x4 acc[2][2][4][2];
#pragma unroll
    for (int a = 0; a < 2; ++a)
#pragma unroll
        for (int b = 0; b < 2; ++b)
#pragma unroll
            for (int m = 0; m < 4; ++m)
#pragma unroll
                for (int n = 0; n < 2; ++n) acc[a][b][m][n] = (f32x4){0.f, 0.f, 0.f, 0.f};
    bf16x8 At[4][2], B0[2][2], B1[2][2];
    const char* cA = (const char*)g.A + (size_t)cur.pm * tstep; const char* cB = (const char*)g.Bt + (size_t)cur.pn * tstep;
    S.a_ready(cur);
    if constexpr (SP2) {
        PG8_STAGE(PG8_SB(0, 0), cB, voffB); PG8_STAGE(PG8_SB(0, 1), cB + hstep, voffB); PG8_STAGE(PG8_SA(0, 0), cA, voffA); PG8_STAGE(PG8_SA(0, 1), cA + hstep, voffA);
        if (wr == 1) PG8_BAR;
        PG8_WAIT_V(2); PG8_BAR;
        PG8_STAGE(PG8_SB(1, 0), cB + kstep, voffB); PG8_STAGE(PG8_SA(1, 0), cA + kstep, voffA); PG8_STAGE(PG8_SB(1, 1), cB + hstep + kstep, voffB);
        PG8_WAIT_V(6); PG8_BAR;
    } else {
        PG8_STAGE(PG8_SB(0, 0), cB, voffB); PG8_STAGE(PG8_SA(0, 0), cA, voffA); PG8_STAGE(PG8_SB(0, 1), cB + hstep, voffB); PG8_STAGE(PG8_SA(0, 1), cA + hstep, voffA);
        if (wr == 1) PG8_BAR;
        PG8_WAIT_V(4); PG8_BAR;
        PG8_STAGE(PG8_SB(1, 0), cB + kstep, voffB); PG8_STAGE(PG8_SA(1, 0), cA + kstep, voffA); PG8_STAGE(PG8_SB(1, 1), cB + hstep + kstep, voffB);
        PG8_WAIT_V(6); PG8_BAR;
    }
    for (;;) {
        const bool has_next = S.next(ui + 1, nxt);
        const char* nA = has_next ? (const char*)g.A + (size_t)nxt.pm * tstep : cA; const char* nB = has_next ? (const char*)g.Bt + (size_t)nxt.pn * tstep : cB;
        for (int t = 0; t < nt; t += 2) {
            const bool last = (t == nt - 2);
            const char* a1 = cA + (size_t)(t + 1) * kstep;
            const char* a2 = last ? nA : cA + (size_t)(t + 2) * kstep; const char* b2 = last ? nB : cB + (size_t)(t + 2) * kstep;
            const char* a3 = a2 + kstep; const char* b3 = b2 + kstep;
            if (last && has_next) S.a_ready(nxt);
            if constexpr (SP2) {
            PG8_LDB(B0, 0, 0); PG8_LDB(B1, 0, 1); PG8_SCHED; PG8_LDA(At, 0, 0); PG8_STAGE(PG8_SA(1, 1), a1 + hstep, voffA);
            PG8_WAIT_V(8); PG8_WAIT_L(0); PG8_BAR; PG8_MMA(0, 0, At, B0); PG8_MMA(0, 1, At, B1); PG8_BAR; PG8_SCHED;
            PG8_LDA(At, 0, 1); PG8_STAGE(PG8_SB(0, 0), b2, voffB); PG8_STAGE(PG8_SB(0, 1), b2 + hstep, voffB); PG8_STAGE(PG8_SA(0, 0), a2, voffA);
            PG8_WAIT_V(8); PG8_WAIT_L(0); PG8_BAR; PG8_MMA(1, 0, At, B0); PG8_MMA(1, 1, At, B1); PG8_BAR; PG8_SCHED;
            PG8_LDB(B0, 1, 0); PG8_LDB(B1, 1, 1); PG8_SCHED; PG8_LDA(At, 1, 0); PG8_STAGE(PG8_SA(0, 1), a2 + hstep, voffA);
            PG8_WAIT_V(8); PG8_WAIT_L(0); PG8_BAR; PG8_MMA(0, 0, At, B0); PG8_MMA(0, 1, At, B1); PG8_BAR; PG8_SCHED;
            PG8_LDA(At, 1, 1); PG8_STAGE(PG8_SB(1, 0), b3, voffB); PG8_STAGE(PG8_SB(1, 1), b3 + hstep, voffB); PG8_STAGE(PG8_SA(1, 0), a3, voffA);
            PG8_WAIT_V(8); PG8_WAIT_L(0); PG8_BAR; PG8_MMA(1, 0, At, B0); PG8_MMA(1, 1, At, B1); PG8_BAR; PG8_SCHED;
            } else {
            PG8_LDB(B0, 0, 0); PG8_SCHED; PG8_LDA(At, 0, 0); PG8_STAGE(PG8_SA(1, 1), a1 + hstep, voffA);
            PG8_WAIT_L(8); PG8_BAR; PG8_WAIT_L(0); PG8_MMA(0, 0, At, B0); PG8_BAR; PG8_SCHED;
            PG8_LDB(B1, 0, 1); PG8_STAGE(PG8_SB(0, 0), b2, voffB);
            PG8_BAR; PG8_WAIT_L(0); PG8_MMA(0, 1, At, B1); PG8_BAR;
            PG8_LDA(At, 0, 1); PG8_STAGE(PG8_SA(0, 0), a2, voffA);
            PG8_BAR; PG8_WAIT_L(0); PG8_MMA(1, 0, At, B0); PG8_BAR; PG8_SCHED;
            PG8_STAGE(PG8_SB(0, 1), b2 + hstep, voffB);
            PG8_WAIT_V(6); PG8_BAR; PG8_MMA(1, 1, At, B1); PG8_BAR;
            PG8_LDB(B0, 1, 0); PG8_SCHED; PG8_LDA(At, 1, 0); PG8_STAGE(PG8_SA(0, 1), a2 + hstep, voffA);
            PG8_WAIT_L(8); PG8_BAR; PG8_WAIT_L(0); PG8_MMA(0, 0, At, B0); PG8_BAR; PG8_SCHED;
            PG8_LDB(B1, 1, 1); PG8_STAGE(PG8_SB(1, 0), b3, voffB);
            PG8_BAR; PG8_WAIT_L(0); PG8_MMA(0, 1, At, B1); PG8_BAR;
            PG8_LDA(At, 1, 1); PG8_STAGE(PG8_SA(1, 0), a3, voffA);
            PG8_BAR; PG8_WAIT_L(0); PG8_MMA(1, 0, At, B0); PG8_BAR; PG8_SCHED;
            PG8_STAGE(PG8_SB(1, 1), b3 + hstep, voffB);
            PG8_WAIT_V(6); PG8_BAR; PG8_MMA(1, 1, At, B1); PG8_BAR;
            }
        }
        if constexpr (ALIGN_EPI) { if (wr == 0) PG8_BAR; }
        if constexpr (!Epi::AFTER_DRAIN) { E(acc, cur, wr, wc, fr, fq); S.done(cur); }
        if (!has_next) break;
#pragma unroll
        for (int a = 0; a < 2; ++a)
#pragma unroll
            for (int b = 0; b < 2; ++b)
#pragma unroll
                for (int m = 0; m < 4; ++m)
#pragma unroll
                    for (int n = 0; n < 2; ++n) acc[a][b][m][n] = (f32x4){0.f, 0.f, 0.f, 0.f};
        cur = nxt; cA = nA; cB = nB; ++ui;
        if constexpr (ALIGN_EPI) { if (wr == 1) PG8_BAR; }
    }
    PG8_WAIT_V(0);
    if constexpr (!ALIGN_EPI) { if (wr == 0) PG8_BAR; }
    PG8_BAR;
    if constexpr (Epi::AFTER_DRAIN) { E.fused(acc, cur, wr, wc, fr, fq, lds, wid, lane); S.done(cur); }
#undef PG8_SA
#undef PG8_SB
#undef PG8_STAGE
#undef PG8_LDA
#undef PG8_LDB
#undef PG8_MMA
#undef PG8_WAIT_V
#undef PG8_WAIT_L
#undef PG8_BAR
#undef PG8_SCHED
}
}

#ifndef PG8_SP2
#define PG8_SP2 true
#endif
#ifndef PG8_ALIGN
#define PG8_ALIGN true
#endif
#ifndef MK_COOP
#define MK_COOP 1
#endif
#if MK_COOP
#include <hip/hip_cooperative_groups.h>
namespace cg = cooperative_groups;
#endif

constexpr int BATCH = 4, SEQ = 8192, D = 1024, M = BATCH * SEQ, DFF = 2816, NQKV = 1536, NH = 16, NKV = 4, HD = 64, CW = 31;
constexpr float EPS = 1e-6f;
constexpr float LOG2E = 1.4426950408889634f;
constexpr float QSCALE = 0.125f * LOG2E;
constexpr int NWAVES = 8;
constexpr int NPHASE = 15;

constexpr size_t MiB = 1u << 20;
constexpr size_t WS_WIN = 2 * MiB, WS_WOUT = 6 * MiB, WS_WQKV = 8 * MiB, WS_WO = 11 * MiB, WS_WGU0 = 13 * MiB, WS_WGU1 = 24 * MiB, WS_WD0 = 35 * MiB, WS_WD1 = 35 * MiB + 5632 * 1024, WS_WEND = 46 * MiB;
constexpr size_t WS_XN = 48 * MiB;
constexpr size_t WS_G0 = 112 * MiB, WS_C0 = 176 * MiB;
constexpr size_t WS_Q = 112 * MiB, WS_K = 176 * MiB, WS_V = 192 * MiB;
constexpr size_t WS_HF = 112 * MiB;
constexpr size_t WS_Y = 288 * MiB;
constexpr size_t WS_END = 416 * MiB;
static_assert(WS_WD1 + (size_t)D * DFF * 2 <= WS_WEND && WS_HF + (size_t)M * DFF * 2 <= WS_Y && WS_Y + (size_t)M * D * 4 <= WS_END, "d_ws map");

constexpr int LDS_BYTES = 147456;

#define GAS __attribute__((address_space(1)))
#define LAS __attribute__((address_space(3)))
typedef unsigned short bf16;
typedef unsigned v4u __attribute__((ext_vector_type(4)));
typedef unsigned v2u __attribute__((ext_vector_type(2)));
typedef float f32x4 __attribute__((ext_vector_type(4)));
typedef float f32x16 __attribute__((ext_vector_type(16)));
typedef short bf16x8 __attribute__((ext_vector_type(8)));
typedef short s16x4 __attribute__((ext_vector_type(4)));
#define LDS_WAIT() asm volatile("s_waitcnt lgkmcnt(0)" ::: "memory")

__device__ __forceinline__ unsigned pk2(float lo, float hi) { unsigned r; asm volatile("v_cvt_pk_bf16_f32 %0, %1, %2" : "=v"(r) : "v"(lo), "v"(hi)); return r; }
__device__ __forceinline__ float bf2f(unsigned short b) { return __builtin_bit_cast(float, (unsigned)b << 16); }
__device__ __forceinline__ float wave_sum(float v) {
#pragma unroll
    for (int o = 1; o < 64; o <<= 1) v += __shfl_xor(v, o);
    return v;
}

struct Frame {
    LAS unsigned char* lds;
    int tid, lane, wave, vcu, G;
};

__device__ __forceinline__ void p0_transpose_item(const float* W, int K, int N, bf16* WT, int k0, int n0, int drow, LAS float* scr, int lane) {
#pragma unroll 8
    for (int i = 0; i < 32; ++i) { const int kk = 2 * i + (lane >> 5); scr[kk * 33 + (lane & 31)] = W[(size_t)(k0 + kk) * N + n0 + (lane & 31)]; }
    LDS_WAIT(); asm volatile("" ::: "memory");
    const int c = lane & 7;
#pragma unroll
    for (int j = 0; j < 4; ++j) { const int n = (lane >> 3) + 8 * j; const LAS float* s = scr + (8 * c) * 33 + n;
        v4u o; o.x = pk2(s[0 * 33], s[1 * 33]); o.y = pk2(s[2 * 33], s[3 * 33]); o.z = pk2(s[4 * 33], s[5 * 33]); o.w = pk2(s[6 * 33], s[7 * 33]);
        *(v4u*)(WT + (size_t)(drow + n) * K + k0 + 8 * c) = o; }
    LDS_WAIT(); asm volatile("" ::: "memory");
}
__device__ __forceinline__ int gate_row(int n0, int half) { const int hsel = n0 >= half ? 1 : 0; const int c = n0 - hsel * half; return 256 * (c >> 7) + 128 * hsel + (c & 127); }


__device__ __forceinline__ void rms_row_to_bf16(const float* xrow, bf16* orow, const f32x4 (&g)[4], int lane) {
    const f32x4* xr = (const f32x4*)xrow + lane;
    f32x4 v[4]; float s = 0.f;
#pragma unroll
    for (int j = 0; j < 4; ++j) { v[j] = xr[64 * j]; s += (v[j].x * v[j].x + v[j].y * v[j].y) + (v[j].z * v[j].z + v[j].w * v[j].w); }
    const float rstd = rsqrtf(wave_sum(s) * (1.f / D) + EPS);
    v2u* o8 = (v2u*)orow + lane;
#pragma unroll
    for (int j = 0; j < 4; ++j) { v2u w; w.x = pk2(v[j].x * rstd * g[j].x, v[j].y * rstd * g[j].y); w.y = pk2(v[j].z * rstd * g[j].z, v[j].w * rstd * g[j].w); o8[64 * j] = w; }
}

__device__ __forceinline__ void thin_phase(const Frame& F, const float* Y, const float* base, float* out, bf16* XN, const float* gpost, const float* gpre) {
    const int gw = F.vcu * NWAVES + F.wave, NGW = F.G * NWAVES, lane = F.lane;
    f32x4 gp[4], gq[4];
#pragma unroll
    for (int j = 0; j < 4; ++j) { gp[j] = ((const f32x4*)gpost)[lane + 64 * j]; gq[j] = gpre ? ((const f32x4*)gpre)[lane + 64 * j] : (f32x4){0.f, 0.f, 0.f, 0.f}; }
    for (int m = gw; m < M; m += NGW) {
        const f32x4* yr = (const f32x4*)(Y + (size_t)m * D) + lane; const f32x4* br = (const f32x4*)(base + (size_t)m * D) + lane;
        f32x4 y[4], h[4]; float s = 0.f;
#pragma unroll
        for (int j = 0; j < 4; ++j) { y[j] = yr[64 * j]; h[j] = br[64 * j]; }
#pragma unroll
        for (int j = 0; j < 4; ++j) s += (y[j].x * y[j].x + y[j].y * y[j].y) + (y[j].z * y[j].z + y[j].w * y[j].w);
        const float rstd = rsqrtf(wave_sum(s) * (1.f / D) + EPS);
        f32x4* orow = (f32x4*)(out + (size_t)m * D) + lane; float s2 = 0.f;
#pragma unroll
        for (int j = 0; j < 4; ++j) { h[j] = h[j] + y[j] * rstd * gp[j]; orow[64 * j] = h[j]; s2 += (h[j].x * h[j].x + h[j].y * h[j].y) + (h[j].z * h[j].z + h[j].w * h[j].w); }
        if (gpre) {
            const float r2 = rsqrtf(wave_sum(s2) * (1.f / D) + EPS);
            v2u* o8 = (v2u*)(XN + (size_t)m * D) + lane;
#pragma unroll
            for (int j = 0; j < 4; ++j) { v2u w; w.x = pk2(h[j].x * r2 * gq[j].x, h[j].y * r2 * gq[j].y); w.y = pk2(h[j].z * r2 * gq[j].z, h[j].w * r2 * gq[j].w); o8[64 * j] = w; }
        }
    }
}

constexpr int CV_SEG = 128;
constexpr int CV_TILE = 0;
constexpr int CV_LNG = 65536, CV_LNB = 65536 + 4096;
template <int C4>
__device__ __forceinline__ void conv_chunk(float (&win0)[32], float (&win1)[32], const float (&w0)[CW], const float (&w1)[CW], unsigned (&buf)[8], const GAS bf16*& gp, bool more, float bias0, float bias1,
                                           LAS unsigned char* lds, bf16* orow, int tid, int wave, int lane) {
    typedef float f32x2 __attribute__((ext_vector_type(2)));
    LAS f32x2* tile = (LAS f32x2*)(lds + CV_TILE + (C4 & 1) * 32768);
#pragma unroll
    for (int kk = 0; kk < 8; ++kk) {
        const int k = C4 * 8 + kk;
        win0[k] = __builtin_bit_cast(float, buf[kk] << 16); win1[k] = __builtin_bit_cast(float, buf[kk] & 0xffff0000u);
        if (more) { asm volatile("" : "+v"(gp)); buf[kk] = *(const GAS unsigned*)gp; gp += D; }
        float a0 = bias0, a1 = bias1;
#pragma unroll
        for (int j = 0; j < CW; ++j) { a0 = __builtin_fmaf(w0[j], win0[(2 + k + j) & 31], a0); a1 = __builtin_fmaf(w1[j], win1[(2 + k + j) & 31], a1); }
        tile[kk * 512 + tid] = (f32x2){a0, a1};
    }
    __syncthreads();
    {
        const LAS f32x4* tr = (const LAS f32x4*)(lds + CV_TILE + (C4 & 1) * 32768 + wave * 4096) + lane;
        const LAS f32x4* lg = (const LAS f32x4*)(lds + CV_LNG) + lane; const LAS f32x4* lb = (const LAS f32x4*)(lds + CV_LNB) + lane;
        f32x4 v[4]; float sm = 0.f, q = 0.f;
#pragma unroll
        for (int j = 0; j < 4; ++j) { v[j] = tr[64 * j]; sm += (v[j].x + v[j].y) + (v[j].z + v[j].w); q += (v[j].x * v[j].x + v[j].y * v[j].y) + (v[j].z * v[j].z + v[j].w * v[j].w); }
        sm = wave_sum(sm); q = wave_sum(q);
        const float mean = sm * (1.f / D); const float rstd = rsqrtf(fmaxf(q * (1.f / D) - mean * mean, 0.f) + EPS);
        v2u* o8 = (v2u*)(orow + (size_t)wave * D) + lane;
#pragma unroll
        for (int j = 0; j < 4; ++j) { const f32x4 g = lg[64 * j], bb = lb[64 * j]; f32x4 y = (v[j] - mean) * rstd * g + bb;
            y.x = y.x * sigmoid_f(y.x); y.y = y.y * sigmoid_f(y.y); y.z = y.z * sigmoid_f(y.z); y.w = y.w * sigmoid_f(y.w);
            v2u w; w.x = pk2(y.x, y.y); w.y = pk2(y.z, y.w); o8[64 * j] = w; }
    }
}

__device__ __forceinline__ void conv_phase(const Frame& F, const bf16* G0, bf16* C0, const float* dww, const float* dwb, const float* lng, const float* lnb) {
    const int tid = F.tid, c = 2 * tid;
    for (int i = tid; i < D; i += NWAVES * 64) { ((LAS float*)(F.lds + CV_LNG))[i] = lng[i]; ((LAS float*)(F.lds + CV_LNB))[i] = lnb[i]; }
    float w0[CW], w1[CW];
    { const GAS float* wp = (const GAS float*)(dww + c);
#pragma unroll
      for (int j = 0; j < CW; ++j) { asm volatile("" : "+v"(wp)); typedef float f32x2g __attribute__((ext_vector_type(2))); const f32x2g w = *(const GAS f32x2g*)wp; w0[j] = w.x; w1[j] = w.y; wp += D; } }
    const float2 bb = *(const float2*)(dwb + c);
    __syncthreads();
    for (int seg = F.vcu; seg < M / CV_SEG; seg += F.G) {
        const int t0 = seg * CV_SEG; const bool first = (t0 % SEQ) == 0;
        float win0[32], win1[32];
        win0[0] = win0[1] = win1[0] = win1[1] = 0.f;
        const GAS bf16* gp = (const GAS bf16*)(G0 + ((long)t0 - 30) * D + c);
#pragma unroll
        for (int s = 2; s < 32; ++s) { unsigned v = 0u; if (!first) { asm volatile("" : "+v"(gp)); v = *(const GAS unsigned*)gp; } gp += D;
            win0[s] = __builtin_bit_cast(float, v << 16); win1[s] = __builtin_bit_cast(float, v & 0xffff0000u); }
        unsigned buf[8];
#pragma unroll
        for (int kk = 0; kk < 8; ++kk) { asm volatile("" : "+v"(gp)); buf[kk] = *(const GAS unsigned*)gp; gp += D; }
        for (int blk = 0; blk < CV_SEG / 32; ++blk) {
            const int r0 = t0 + blk * 32; const bool notlast = blk + 1 < CV_SEG / 32;
            conv_chunk<0>(win0, win1, w0, w1, buf, gp, true, bb.x, bb.y, F.lds, C0 + (size_t)r0 * D, tid, F.wave, F.lane);
            conv_chunk<1>(win0, win1, w0, w1, buf, gp, true, bb.x, bb.y, F.lds, C0 + (size_t)(r0 + 8) * D, tid, F.wave, F.lane);
            conv_chunk<2>(win0, win1, w0, w1, buf, gp, true, bb.x, bb.y, F.lds, C0 + (size_t)(r0 + 16) * D, tid, F.wave, F.lane);
            conv_chunk<3>(win0, win1, w0, w1, buf, gp, notlast, bb.x, bb.y, F.lds, C0 + (size_t)(r0 + 24) * D, tid, F.wave, F.lane);
        }
    }
    __syncthreads();
}

constexpr int AT_KS = 0;
constexpr int AT_VT = 32768;
constexpr int AT_VLD = 260;
constexpr int AT_BIAS = AT_VT + 64 * AT_VLD * 2 + 512;
constexpr int AT_SINK = AT_BIAS + 16 * 128 * 4;
static_assert(AT_BIAS % 16 == 0 && AT_SINK + 64 <= 131072, "attention LDS map");
__device__ __forceinline__ int t5_bucket(int d) {
    if (d < 16) return d;
    int b = 16;
    b += (d >= 19) + (d >= 21) + (d >= 24) + (d >= 27) + (d >= 31) + (d >= 35) + (d >= 40) + (d >= 46) + (d >= 52) + (d >= 59) + (d >= 67) + (d >= 77) + (d >= 87) + (d >= 99) + (d >= 113);
    return b;
}
__device__ __forceinline__ void attn_phase(const Frame& F, const bf16* Q, const bf16* Kg, const bf16* Vg, bf16* O, const float* sinks, const float* rel_bias) {
    LAS unsigned char* lds = F.lds;
    LAS float* bias2 = (LAS float*)(lds + AT_BIAS); LAS float* sink2 = (LAS float*)(lds + AT_SINK);
    const int tid = F.tid, lane = F.lane, wave = F.wave, r32 = lane & 31, hi = lane >> 5;
    for (int idx = tid; idx < 16 * 128; idx += NWAVES * 64) { const int h = idx >> 7, d = idx & 127; bias2[idx] = rel_bias[t5_bucket(d) * NH + h] * LOG2E; }
    if (tid < 16) sink2[tid] = sinks[tid] * LOG2E;
    __syncthreads();
    constexpr int NUNIT = BATCH * NKV * (SEQ / 128);
    const int upw = (NUNIT + F.G - 1) / F.G;
    for (int ui = 0; ui < upw; ++ui) {
        const int unit = F.vcu * upw + ui; if (unit >= NUNIT) break;
        const int n = unit & 63, kv = (unit >> 6) & 3, b = unit >> 8;
        const long rowbase = (long)b * SEQ + n * 128 - 128;
#pragma unroll
        for (int i = 0; i < 4; ++i) { const int q = tid + 512 * i, row = q >> 3, ch = q & 7; const bool ok = (n > 0) || (row >= 128);
            v4u kq = (v4u){0u, 0u, 0u, 0u}, vq = (v4u){0u, 0u, 0u, 0u};
            if (ok) { kq = *(const v4u*)(Kg + (size_t)(rowbase + row) * 256 + kv * 64 + ch * 8); vq = *(const v4u*)(Vg + (size_t)(rowbase + row) * 256 + kv * 64 + ch * 8); }
            *(LAS v4u*)(lds + AT_KS + row * 128 + ((ch ^ ((row >> 1) & 7)) << 4)) = kq;
            LAS unsigned short* vt = (LAS unsigned short*)(lds + AT_VT) + (ch * 8) * AT_VLD + row;
            vt[0 * AT_VLD] = (unsigned short)(vq.x & 0xffffu); vt[1 * AT_VLD] = (unsigned short)(vq.x >> 16);
            vt[2 * AT_VLD] = (unsigned short)(vq.y & 0xffffu); vt[3 * AT_VLD] = (unsigned short)(vq.y >> 16);
            vt[4 * AT_VLD] = (unsigned short)(vq.z & 0xffffu); vt[5 * AT_VLD] = (unsigned short)(vq.z >> 16);
            vt[6 * AT_VLD] = (unsigned short)(vq.w & 0xffffu); vt[7 * AT_VLD] = (unsigned short)(vq.w >> 16); }
        __syncthreads();
        const int g = wave >> 1, head = kv * 4 + g;
        const float snk = sink2[head];
        for (int sb = 0; sb < 2; ++sb) {
            const int qi = (wave & 1) * 2 + sb;
            const size_t rowq = (size_t)b * SEQ + n * 128 + qi * 32 + r32;
            bf16x8 qf[4];
#pragma unroll
            for (int kk = 0; kk < 4; ++kk) qf[kk] = *(const bf16x8*)(Q + rowq * D + head * HD + kk * 16 + hi * 8);
            f32x16 s[5];
#pragma unroll
            for (int t = 0; t < 5; ++t) { const int krow = (qi + t) * 32 + r32; const LAS unsigned char* kb = lds + AT_KS + krow * 128; const int sw = (krow >> 1) & 7;
                f32x16 a = {};
#pragma unroll
                for (int kk = 0; kk < 4; ++kk) { const bf16x8 kf = *(const LAS bf16x8*)(kb + (((2 * kk + hi) ^ sw) << 4)); a = __builtin_amdgcn_mfma_f32_32x32x16_bf16(kf, qf[kk], a, 0, 0, 0); }
                s[t] = a; }
            const int iq = qi * 32 + r32;
            float mx = snk;
#pragma unroll
            for (int t = 0; t < 5; ++t)
#pragma unroll
                for (int r = 0; r < 16; ++r) { const int sidx = (qi + t) * 32 + (r & 3) + 8 * (r >> 2) + 4 * hi; const int dist = iq + 128 - sidx;
                    const bool ok = (dist >= 0) && (dist < 128) && ((n > 0) || (sidx >= 128));
                    const float v = ok ? s[t][r] + bias2[head * 128 + (dist & 127)] : -INFINITY;
                    s[t][r] = v; mx = fmaxf(mx, v); }
            mx = fmaxf(mx, __shfl_xor(mx, 32));
            float l = 0.f;
#pragma unroll
            for (int t = 0; t < 5; ++t)
#pragma unroll
                for (int r = 0; r < 16; ++r) { const float p = __builtin_amdgcn_exp2f(s[t][r] - mx); s[t][r] = p; l += p; }
            l += __shfl_xor(l, 32);
            l += __builtin_amdgcn_exp2f(snk - mx);
            f32x16 o[2]; o[0] = (f32x16){}; o[1] = (f32x16){};
#pragma unroll
            for (int t = 0; t < 5; ++t)
#pragma unroll
                for (int ks = 0; ks < 2; ++ks) {
                    v4u pw; pw.x = pk2(s[t][8 * ks + 0], s[t][8 * ks + 1]); pw.y = pk2(s[t][8 * ks + 2], s[t][8 * ks + 3]); pw.z = pk2(s[t][8 * ks + 4], s[t][8 * ks + 5]); pw.w = pk2(s[t][8 * ks + 6], s[t][8 * ks + 7]);
                    const bf16x8 pb = __builtin_bit_cast(bf16x8, pw);
#pragma unroll
                    for (int db = 0; db < 2; ++db) { const LAS unsigned short* vp = (const LAS unsigned short*)(lds + AT_VT) + (db * 32 + r32) * AT_VLD + (qi + t) * 32 + 16 * ks + 4 * hi;
                        const s16x4 lo = *(const LAS s16x4*)vp, hh = *(const LAS s16x4*)(vp + 8);
                        const bf16x8 va = (bf16x8){lo[0], lo[1], lo[2], lo[3], hh[0], hh[1], hh[2], hh[3]};
                        o[db] = __builtin_amdgcn_mfma_f32_32x32x16_bf16(va, pb, o[db], 0, 0, 0); } }
            const float inv = 1.0f / l;
            bf16* orow = O + rowq * D + head * HD;
#pragma unroll
            for (int db = 0; db < 2; ++db)
#pragma unroll
                for (int gq = 0; gq < 4; ++gq) { v2u w; w.x = pk2(o[db][4 * gq + 0] * inv, o[db][4 * gq + 1] * inv); w.y = pk2(o[db][4 * gq + 2] * inv, o[db][4 * gq + 3] * inv);
                    *(v2u*)(orow + db * 32 + 8 * gq + 4 * hi) = w; }
        }
        __syncthreads();
    }
}

struct Args { const float* in[21]; float* out; unsigned char* ws; int ph_lo, ph_hi; };
static_assert(sizeof(Args) == 21 * 8 + 8 + 8 + 8, "Args has no padding");

__global__ void __launch_bounds__(NWAVES * 64, 2) mk_fwd(Args args) {
    extern __shared__ __attribute__((aligned(16))) unsigned char lds_raw[];
    Frame F;
    F.lds = (LAS unsigned char*)lds_raw;
    F.tid = threadIdx.x; F.lane = F.tid & 63; F.wave = __builtin_amdgcn_readfirstlane(F.tid >> 6);
    F.G = gridDim.x; { const int bx = blockIdx.x; F.vcu = (F.G % 8 == 0) ? (bx % 8) * (F.G / 8) + bx / 8 : bx; }
    unsigned char* ws = args.ws;
    const float* x = args.in[0];
    const float* mix_pre_g = args.in[1]; const float* mix_post_g = args.in[2]; const float* ffn_pre_g = args.in[3]; const float* ffn_post_g = args.in[4];
    float* out = args.out;
    bf16* XN = (bf16*)(ws + WS_XN); bf16* G0 = (bf16*)(ws + WS_G0); bf16* C0 = (bf16*)(ws + WS_C0); bf16* HF = (bf16*)(ws + WS_HF);
    bf16* Qb = (bf16*)(ws + WS_Q); bf16* Kb = (bf16*)(ws + WS_K); bf16* Vb = (bf16*)(ws + WS_V); float* Y = (float*)(ws + WS_Y);
#if MK_COOP
    cg::grid_group grid = cg::this_grid();
#endif
#ifndef PH_MASK
#define PH_MASK 0x7fff
#endif
#define PH_ON(k) ((PH_MASK >> (k)) & 1)
    for (int ph = args.ph_lo; ph < args.ph_hi; ++ph) {
        { int t_ = threadIdx.x; asm volatile("" : "+v"(t_)); F.tid = t_; F.lane = t_ & 63; F.wave = __builtin_amdgcn_readfirstlane(t_ >> 6); }
        { long z_ = 0; asm volatile("" : "+s"(z_)); ws = args.ws + z_; out = args.out + z_; x = args.in[0] + z_; }
        XN = (bf16*)(ws + WS_XN); G0 = (bf16*)(ws + WS_G0); C0 = (bf16*)(ws + WS_C0); HF = (bf16*)(ws + WS_HF);
        Qb = (bf16*)(ws + WS_Q); Kb = (bf16*)(ws + WS_K); Vb = (bf16*)(ws + WS_V); Y = (float*)(ws + WS_Y);
        if (ph == 0 && PH_ON(0)) {
            LAS float* scr = (LAS float*)(F.lds + F.wave * 16384);
            const int gw = F.vcu * NWAVES + F.wave, NGW = F.G * NWAVES;
            int it0 = 0;
#define P0_JOB(Wp, WTp, Kd, Nd, halfd) do { const float* W_ = (Wp); bf16* WT_ = (bf16*)(WTp); const int K_ = (Kd), N_ = (Nd), half_ = (halfd); const int nblk = N_ / 32, nitems = (K_ / 64) * nblk; \
                const int first = ((gw - it0) % NGW + NGW) % NGW; \
                for (int it = first; it < nitems; it += NGW) { const int kb = it / nblk, nb = it % nblk, n0 = 32 * nb; const int drow = half_ ? gate_row(n0, half_) : n0; \
                    p0_transpose_item(W_, K_, N_, WT_, 64 * kb, n0, drow, scr, F.lane); } \
                it0 += nitems; } while (0)
            P0_JOB(args.in[5], ws + WS_WIN, D, 2 * D, D);
            P0_JOB(args.in[11], ws + WS_WOUT, D, D, 0);
            P0_JOB(args.in[13], ws + WS_WQKV, D, NQKV, 0);
            P0_JOB(args.in[15], ws + WS_WO, D, D, 0);
            P0_JOB(args.in[19], ws + WS_WGU0, D, 2 * DFF, DFF);
            P0_JOB(args.in[19] + (size_t)D * 2 * DFF, ws + WS_WGU1, D, 2 * DFF, DFF);
            P0_JOB(args.in[20], ws + WS_WD0, DFF, D, 0);
            P0_JOB(args.in[20] + (size_t)DFF * D, ws + WS_WD1, DFF, D, 0);
#undef P0_JOB
            f32x4 g[4];
#pragma unroll
            for (int j = 0; j < 4; ++j) g[j] = ((const f32x4*)mix_pre_g)[F.lane + 64 * j];
            for (int m = gw; m < M; m += NGW) rms_row_to_bf16(x + (size_t)m * D, XN + (size_t)m * D, g, F.lane);
        } else if ((ph == 1 || ph == 5 || ph == 12) && PH_ON(1)) {
            if (ph == 1) { pg8::Gemm gm{XN, (const bf16*)(ws + WS_WIN), M, 2 * D, D}; pg8::StaticOrder S; S.init(M, 2 * D, F.G, (int)blockIdx.x);
                pg8::EpiGate<0> E{G0, D, args.in[6], D};
                pg8::gemm_phase<pg8::EpiGate<0>, pg8::StaticOrder, PG8_ALIGN, PG8_SP2>(F.lds, gm, S, E, F.tid);
            } else { pg8::Gemm gm{XN, (const bf16*)(ws + (ph == 5 ? WS_WGU0 : WS_WGU1)), M, 2 * DFF, D}; pg8::StaticOrder S; S.init(M, 2 * DFF, F.G, (int)blockIdx.x);
                pg8::EpiGate<1> E{HF, DFF, nullptr, DFF};
                pg8::gemm_phase<pg8::EpiGate<1>, pg8::StaticOrder, PG8_ALIGN, PG8_SP2>(F.lds, gm, S, E, F.tid); }
        } else if (ph == 2 && PH_ON(2)) {
            conv_phase(F, G0, C0, args.in[7], args.in[8], args.in[9], args.in[10]);
        } else if ((ph == 3 || ph == 6 || ph == 10 || ph == 13) && PH_ON(3)) {
            pg8::Gemm gm; const float* bias;
            if (ph == 3) { gm = pg8::Gemm{C0, (const bf16*)(ws + WS_WOUT), M, D, D}; bias = args.in[12]; }
            else if (ph == 10) { gm = pg8::Gemm{Qb, (const bf16*)(ws + WS_WO), M, D, D}; bias = args.in[16]; }
            else { gm = pg8::Gemm{HF, (const bf16*)(ws + (ph == 6 ? WS_WD0 : WS_WD1)), M, D, DFF}; bias = nullptr; }
            pg8::StaticOrder S; S.init(M, D, F.G, (int)blockIdx.x);
            pg8::EpiF32 E{Y, D, bias};
            pg8::gemm_phase<pg8::EpiF32, pg8::StaticOrder, PG8_ALIGN, PG8_SP2>(F.lds, gm, S, E, F.tid);
        } else if (ph == 4 && PH_ON(4)) { thin_phase(F, Y, x, out, XN, mix_post_g, ffn_pre_g);
        } else if (ph == 7 && PH_ON(4)) { thin_phase(F, Y, out, out, XN, ffn_post_g, mix_pre_g + D);
        } else if (ph == 11 && PH_ON(4)) { thin_phase(F, Y, out, out, XN, mix_post_g + D, ffn_pre_g + D);
        } else if (ph == 14 && PH_ON(4)) { thin_phase(F, Y, out, out, XN, ffn_post_g + D, nullptr);
        } else if (ph == 8 && PH_ON(8)) {
            pg8::Gemm gm{XN, (const bf16*)(ws + WS_WQKV), M, NQKV, D}; pg8::StaticOrder S; S.init(M, NQKV, F.G, (int)blockIdx.x);
            pg8::EpiQKV E{Qb, Kb, Vb, args.in[14], QSCALE};
            pg8::gemm_phase<pg8::EpiQKV, pg8::StaticOrder, PG8_ALIGN, PG8_SP2>(F.lds, gm, S, E, F.tid);
        } else if (ph == 9 && PH_ON(9)) {
            attn_phase(F, Qb, Kb, Vb, Qb, args.in[17], args.in[18]);
        }
#if MK_COOP
        if (ph + 1 < args.ph_hi) grid.sync();
#endif
    }
}

extern "C" void kernel_launch(void* const* d_in, const int* in_sizes, int n_in, void* d_out, int out_size, void* d_ws, size_t ws_size, hipStream_t stream) {
    static int grid = 0;
    if (grid == 0) {
        if (n_in != 21 || in_sizes[0] != M * D || out_size != M * D || ws_size < WS_END) { fprintf(stderr, "kernel_launch: unexpected shapes (n_in %d, in0 %d, out %d, ws %zu)\n", n_in, n_in > 0 ? in_sizes[0] : -1, out_size, ws_size); grid = -1; return; }
        int dev = 0, cus = 0, per_cu = 0;
        if (hipGetDevice(&dev) != hipSuccess || hipDeviceGetAttribute(&cus, hipDeviceAttributeMultiprocessorCount, dev) != hipSuccess) { grid = -1; return; }
        if (hipFuncSetAttribute((const void*)mk_fwd, hipFuncAttributeMaxDynamicSharedMemorySize, LDS_BYTES) != hipSuccess) { fprintf(stderr, "kernel_launch: hipFuncSetAttribute failed\n"); grid = -1; return; }
        if (hipOccupancyMaxActiveBlocksPerMultiprocessor(&per_cu, (const void*)mk_fwd, NWAVES * 64, LDS_BYTES) != hipSuccess || per_cu < 1) { fprintf(stderr, "kernel_launch: occupancy query says %d\n", per_cu); per_cu = 1; }
        (void)hipGetLastError();
        grid = cus * 1;
    }
    if (grid < 0) return;
    Args a{};
    for (int i = 0; i < 21; ++i) a.in[i] = (const float*)d_in[i];
    a.out = (float*)d_out; a.ws = (unsigned char*)d_ws;
#if MK_COOP
    a.ph_lo = 0; a.ph_hi = NPHASE;
    void* kargs[] = {&a};
    hipError_t e = hipLaunchCooperativeKernel((const void*)mk_fwd, dim3(grid), dim3(NWAVES * 64), kargs, LDS_BYTES, stream);
    if (e != hipSuccess) fprintf(stderr, "kernel_launch: cooperative launch failed: %s (grid %d)\n", hipGetErrorString(e), grid);
#else
    for (int ph = 0; ph < NPHASE; ++ph) { a.ph_lo = ph; a.ph_hi = ph + 1; hipLaunchKernelGGL(mk_fwd, dim3(grid), dim3(NWAVES * 64), LDS_BYTES, stream, a); }
#endif
}
```

```cpp
#include <hip/hip_runtime.h>
#include <cstdio>
#include <cstdint>
__device__ __forceinline__ float sigmoid_f(float x) { return __builtin_amdgcn_rcpf(1.0f + __builtin_amdgcn_exp2f(-1.4426950408889634f * x)); }
namespace pg8 {
#define PG8_LAS __attribute__((address_space(3)))
typedef unsigned short bf16_t;
typedef short bf16x8 __attribute__((ext_vector_type(8)));
typedef float f32x4 __attribute__((ext_vector_type(4)));
typedef unsigned u32x4 __attribute__((ext_vector_type(4)));
constexpr int BM = 256, BK = 64, HALF = 128, HTB = HALF * BK * 2  , STAGE_BYTES = 8 * HTB, NXCD = 8, WGM = 8;

__host__ __device__ __forceinline__ int lds_byte(int r, int c) { const int st = (r >> 4) * 2 + (c >> 5), rr = r & 15, cc = c & 31, ob = rr * 64 + cc * 2; return st * 1024 + (ob ^ (((ob >> 9) & 1) << 5)); }
__host__ __device__ __forceinline__ void stage_rc(int b, int& R, int& C) { const int st = b / 1024, sb = b % 1024, swz = sb ^ (((sb >> 9) & 1) << 5); R = (st >> 1) * 16 + swz / 64; C = (st & 1) * 32 + (swz % 64) / 2; }
__host__ __device__ __forceinline__ int perm32(int rho) { const int n = rho >> 4, i = rho & 15; return 8 * (i >> 2) + 4 * n + (i & 3); }

struct Unit { int pm, pn; };
struct Gemm { const bf16_t* A; const bf16_t* Bt; int M, N, K; };

struct StaticOrder {
    int nM, nN, nwg, G, c;
    __host__ __device__ void init(int M, int N, int G_, int c_) { nM = M / BM; nN = N / BM; nwg = nM * nN; G = G_; c = c_; }
    __host__ __device__ bool next(int i, Unit& u) const {
        const long L = (long)i * G + c; if (L >= nwg) return false;
        int wgid = (int)L; { const int q = nwg / NXCD, r = nwg % NXCD, xcd = wgid % NXCD, off = wgid / NXCD; wgid = (xcd < r ? xcd * (q + 1) : r * (q + 1) + (xcd - r) * q) + off; }
        const int nig = WGM * nN, gid = wgid / nig, fm = gid * WGM, gsz = (nM - fm) < WGM ? (nM - fm) : WGM;
        u.pm = fm + ((wgid % nig) % gsz); u.pn = (wgid % nig) / gsz; return true;
    }
    __device__ __forceinline__ void a_ready(const Unit&) const {}
    __device__ __forceinline__ void done(const Unit&) const {}
};


__device__ __forceinline__ unsigned cvt_pk_bf16(float lo, float hi) { unsigned r; asm volatile("v_cvt_pk_bf16_f32 %0, %1, %2" : "=v"(r) : "v"(lo), "v"(hi)); return r; }

struct EpiF32 {
    static constexpr bool PERM = false, AFTER_DRAIN = false;
    float* C; int ldc; const float* bias;
    __device__ __forceinline__ void operator()(const f32x4 (&acc)[2][2][4][2], const Unit& u, int wr, int wc, int fr, int fq) const {
        const int row0 = u.pm * BM + wr * 64 + fr, col0 = u.pn * BM + wc * 32 + 4 * fq;
        f32x4 bv[2][2];
#pragma unroll
        for (int bj = 0; bj < 2; ++bj)
#pragma unroll
            for (int n = 0; n < 2; ++n) bv[bj][n] = bias ? *(const f32x4*)(bias + col0 + bj * HALF + n * 16) : (f32x4){0.f, 0.f, 0.f, 0.f};
#pragma unroll
        for (int ai = 0; ai < 2; ++ai)
#pragma unroll
            for (int m = 0; m < 4; ++m) { float* rowp = C + (size_t)(row0 + ai * HALF + m * 16) * ldc + col0;
#pragma unroll
                for (int bj = 0; bj < 2; ++bj)
#pragma unroll
                    for (int n = 0; n < 2; ++n) *(f32x4*)(rowp + bj * HALF + n * 16) = acc[ai][bj][m][n] + bv[bj][n]; }
    }
};
template <int ACT> struct EpiGate {
    static constexpr bool PERM = true, AFTER_DRAIN = false;
    bf16_t* O; int ldc; const float* bias; int half_cols;
    __device__ __forceinline__ void operator()(const f32x4 (&acc)[2][2][4][2], const Unit& u, int wr, int wc, int fr, int fq) const {
        const int row0 = u.pm * BM + wr * 64 + fr, oc0 = u.pn * HALF + wc * 32 + 8 * fq;
        f32x4 bv[2][2];
#pragma unroll
        for (int bj = 0; bj < 2; ++bj)
#pragma unroll
            for (int n = 0; n < 2; ++n) bv[bj][n] = bias ? *(const f32x4*)(bias + bj * half_cols + oc0 + 4 * n) : (f32x4){0.f, 0.f, 0.f, 0.f};
#pragma unroll
        for (int ai = 0; ai < 2; ++ai)
#pragma unroll
            for (int m = 0; m < 4; ++m) { bf16_t* rowp = O + (size_t)(row0 + ai * HALF + m * 16) * ldc + oc0;
                float r[8];
#pragma unroll
                for (int n = 0; n < 2; ++n) { const f32x4 a = acc[ai][0][m][n] + bv[0][n], b = acc[ai][1][m][n] + bv[1][n];
#pragma unroll
                    for (int j = 0; j < 4; ++j) r[4 * n + j] = (ACT == 0) ? a[j] * sigmoid_f(b[j]) : a[j] * sigmoid_f(a[j]) * b[j]; }
                u32x4 w; w.x = cvt_pk_bf16(r[0], r[1]); w.y = cvt_pk_bf16(r[2], r[3]); w.z = cvt_pk_bf16(r[4], r[5]); w.w = cvt_pk_bf16(r[6], r[7]);
                *(u32x4*)rowp = w; asm volatile("" ::: "memory"); }
    }
};
struct EpiQKV {
    static constexpr bool PERM = true, AFTER_DRAIN = false;
    bf16_t* Q; bf16_t* Kp; bf16_t* Vp; const float* bias; float qscale;
    __device__ __forceinline__ void operator()(const f32x4 (&acc)[2][2][4][2], const Unit& u, int wr, int wc, int fr, int fq) const {
        const int row0 = u.pm * BM + wr * 64 + fr; const int colt = u.pn * BM;
        bf16_t* base; int ldc, c0; float sc = 1.f;
        if (colt < 1024) { base = Q; ldc = 1024; c0 = colt; sc = qscale; } else if (colt < 1280) { base = Kp; ldc = 256; c0 = 0; } else { base = Vp; ldc = 256; c0 = 0; }
        const int col0 = c0 + wc * 32 + 8 * fq, bcol0 = colt + wc * 32 + 8 * fq;
        f32x4 bv[2][2];
#pragma unroll
        for (int bj = 0; bj < 2; ++bj)
#pragma unroll
            for (int n = 0; n < 2; ++n) bv[bj][n] = *(const f32x4*)(bias + bcol0 + bj * HALF + 4 * n);
#pragma unroll
        for (int ai = 0; ai < 2; ++ai)
#pragma unroll
            for (int m = 0; m < 4; ++m) { bf16_t* rowp = base + (size_t)(row0 + ai * HALF + m * 16) * ldc + col0;
#pragma unroll
                for (int bj = 0; bj < 2; ++bj) { const f32x4 v0 = (acc[ai][bj][m][0] + bv[bj][0]) * sc, v1 = (acc[ai][bj][m][1] + bv[bj][1]) * sc;
                    u32x4 w; w.x = cvt_pk_bf16(v0[0], v0[1]); w.y = cvt_pk_bf16(v0[2], v0[3]); w.z = cvt_pk_bf16(v1[0], v1[1]); w.w = cvt_pk_bf16(v1[2], v1[3]);
                    *(u32x4*)(rowp + bj * HALF) = w; } }
    }
};

template <class Epi, class Sched, bool ALIGN_EPI = false, bool SP2 = false>
__device__ __forceinline__ void gemm_phase(PG8_LAS unsigned char* lds, const Gemm g, const Sched& S, const Epi& E, const int tid) {
    const int wid = __builtin_amdgcn_readfirstlane(tid >> 6), lane = tid & 63, wr = wid >> 2, wc = wid & 3, fr = lane & 15, fq = lane >> 4;
    const int K = g.K, nt = K / BK;
    unsigned voffA[2], voffB[2];
#pragma unroll
    for (int i = 0; i < 2; ++i) { int R, C; stage_rc(tid * 16 + i * 8192, R, C); const int Rb = Epi::PERM ? ((R & ~31) + perm32(R & 31)) : R;
        voffA[i] = (unsigned)(R * K + C) * 2u; voffB[i] = (unsigned)(Rb * K + C) * 2u; }
    const size_t kstep = (size_t)(BK * 2);
    const size_t hstep = (size_t)HALF * K * 2;
    const size_t tstep = 2 * hstep;
    const unsigned ldsw = (unsigned)wid * 1024u;
    const int aoff = lds_byte(wr * 64 + fr, fq * 8), boff = lds_byte(wc * 32 + fr, fq * 8);
#define PG8_SA(b, h) (((b) * 2 + (h)) * HTB)
#define PG8_SB(b, h) ((4 + (b) * 2 + (h)) * HTB)
#define PG8_STAGE(bufoff, gbase, voff) do { _Pragma("unroll") for (int _i = 0; _i < 2; ++_i) \
        __builtin_amdgcn_global_load_lds((const unsigned*)((const char*)(gbase) + (voff)[_i]), (PG8_LAS unsigned*)(lds + (bufoff) + ldsw + _i * 8192), 16, 0, 0); } while (0)
#define PG8_LDA(dst, b, h) do { _Pragma("unroll") for (int m = 0; m < 4; ++m) _Pragma("unroll") for (int k = 0; k < 2; ++k) dst[m][k] = *(const PG8_LAS bf16x8*)(lds + PG8_SA(b, h) + aoff + m * 2048 + k * 1024); } while (0)
#define PG8_LDB(dst, b, h) do { _Pragma("unroll") for (int n = 0; n < 2; ++n) _Pragma("unroll") for (int k = 0; k < 2; ++k) dst[n][k] = *(const PG8_LAS bf16x8*)(lds + PG8_SB(b, h) + boff + n * 2048 + k * 1024); } while (0)
#define PG8_MMA(ai, bj, At, Bt) do { __builtin_amdgcn_s_setprio(1); _Pragma("unroll") for (int m = 0; m < 4; ++m) _Pragma("unroll") for (int n = 0; n < 2; ++n) _Pragma("unroll") for (int k = 0; k < 2; ++k) \
        acc[ai][bj][m][n] = __builtin_amdgcn_mfma_f32_16x16x32_bf16(Bt[n][k], At[m][k], acc[ai][bj][m][n], 0, 0, 0); __builtin_amdgcn_s_setprio(0); } while (0)
#define PG8_WAIT_V(n) asm volatile("s_waitcnt vmcnt(" #n ")" ::: "memory")
#define PG8_WAIT_L(n) asm volatile("s_waitcnt lgkmcnt(" #n ")" ::: "memory")
#define PG8_BAR __builtin_amdgcn_s_barrier()
#define PG8_SCHED __builtin_amdgcn_sched_barrier(0)
    Unit cur, nxt; int ui = 0;
    if (!S.next(0, cur)) return;
    f32x4 acc[2][2][4][2];
#pragma unroll
    for (int a = 0; a < 2; ++a)
#pragma unroll
        for (int b = 0; b < 2; ++b)
#pragma unroll
            for (int m = 0; m < 4; ++m)
#pragma unroll
                for (int n = 0; n < 2; ++n) acc[a][b][m][n] = (f32x4){0.f, 0.f, 0.f, 0.f};
    bf16x8 At[4][2], B0[2][2], B1[2][2];
    const char* cA = (const char*)g.A + (size_t)cur.pm * tstep; const char* cB = (const char*)g.Bt + (size_t)cur.pn * tstep;
    S.a_ready(cur);
    if constexpr (SP2) {
        PG8_STAGE(PG8_SB(0, 0), cB, voffB); PG8_STAGE(PG8_SB(0, 1), cB + hstep, voffB); PG8_STAGE(PG8_SA(0, 0), cA, voffA); PG8_STAGE(PG8_SA(0, 1), cA + hstep, voffA);
        if (wr == 1) PG8_BAR;
        PG8_WAIT_V(2); PG8_BAR;
        PG8_STAGE(PG8_SB(1, 0), cB + kstep, voffB); PG8_STAGE(PG8_SA(1, 0), cA + kstep, voffA); PG8_STAGE(PG8_SB(1, 1), cB + hstep + kstep, voffB);
        PG8_WAIT_V(6); PG8_BAR;
    } else {
        PG8_STAGE(PG8_SB(0, 0), cB, voffB); PG8_STAGE(PG8_SA(0, 0), cA, voffA); PG8_STAGE(PG8_SB(0, 1), cB + hstep, voffB); PG8_STAGE(PG8_SA(0, 1), cA + hstep, voffA);
        if (wr == 1) PG8_BAR;
        PG8_WAIT_V(4); PG8_BAR;
        PG8_STAGE(PG8_SB(1, 0), cB + kstep, voffB); PG8_STAGE(PG8_SA(1, 0), cA + kstep, voffA); PG8_STAGE(PG8_SB(1, 1), cB + hstep + kstep, voffB);
        PG8_WAIT_V(6); PG8_BAR;
    }
    for (;;) {
        const bool has_next = S.next(ui + 1, nxt);
        const char* nA = has_next ? (const char*)g.A + (size_t)nxt.pm * tstep : cA; const char* nB = has_next ? (const char*)g.Bt + (size_t)nxt.pn * tstep : cB;
        for (int t = 0; t < nt; t += 2) {
            const bool last = (t == nt - 2);
            const char* a1 = cA + (size_t)(t + 1) * kstep;
            const char* a2 = last ? nA : cA + (size_t)(t + 2) * kstep; const char* b2 = last ? nB : cB + (size_t)(t + 2) * kstep;
            const char* a3 = a2 + kstep; const char* b3 = b2 + kstep;
            if (last && has_next) S.a_ready(nxt);
            if constexpr (SP2) {
            PG8_LDB(B0, 0, 0); PG8_LDB(B1, 0, 1); PG8_SCHED; PG8_LDA(At, 0, 0); PG8_STAGE(PG8_SA(1, 1), a1 + hstep, voffA);
            PG8_WAIT_V(8); PG8_WAIT_L(0); PG8_BAR; PG8_MMA(0, 0, At, B0); PG8_MMA(0, 1, At, B1); PG8_BAR; PG8_SCHED;
            PG8_LDA(At, 0, 1); PG8_STAGE(PG8_SB(0, 0), b2, voffB); PG8_STAGE(PG8_SB(0, 1), b2 + hstep, voffB); PG8_STAGE(PG8_SA(0, 0), a2, voffA);
            PG8_WAIT_V(8); PG8_WAIT_L(0); PG8_BAR; PG8_MMA(1, 0, At, B0); PG8_MMA(1, 1, At, B1); PG8_BAR; PG8_SCHED;
            PG8_LDB(B0, 1, 0); PG8_LDB(B1, 1, 1); PG8_SCHED; PG8_LDA(At, 1, 0); PG8_STAGE(PG8_SA(0, 1), a2 + hstep, voffA);
            PG8_WAIT_V(8); PG8_WAIT_L(0); PG8_BAR; PG8_MMA(0, 0, At, B0); PG8_MMA(0, 1, At, B1); PG8_BAR; PG8_SCHED;
            PG8_LDA(At, 1, 1); PG8_STAGE(PG8_SB(1, 0), b3, voffB); PG8_STAGE(PG8_SB(1, 1), b3 + hstep, voffB); PG8_STAGE(PG8_SA(1, 0), a3, voffA);
            PG8_WAIT_V(8); PG8_WAIT_L(0); PG8_BAR; PG8_MMA(1, 0, At, B0); PG8_MMA(1, 1, At, B1); PG8_BAR; PG8_SCHED;
            } else {
            PG8_LDB(B0, 0, 0); PG8_SCHED; PG8_LDA(At, 0, 0); PG8_STAGE(PG8_SA(1, 1), a1 + hstep, voffA);
            PG8_WAIT_L(8); PG8_BAR; PG8_WAIT_L(0); PG8_MMA(0, 0, At, B0); PG8_BAR; PG8_SCHED;
            PG8_LDB(B1, 0, 1); PG8_STAGE(PG8_SB(0, 0), b2, voffB);
            PG8_BAR; PG8_WAIT_L(0); PG8_MMA(0, 1, At, B1); PG8_BAR;
            PG8_LDA(At, 0, 1); PG8_STAGE(PG8_SA(0, 0), a2, voffA);
            PG8_BAR; PG8_WAIT_L(0); PG8_MMA(1, 0, At, B0); PG8_BAR; PG8_SCHED;
            PG8_STAGE(PG8_SB(0, 1), b2 + hstep, voffB);
            PG8_WAIT_V(6); PG8_BAR; PG8_MMA(1, 1, At, B1); PG8_BAR;
            PG8_LDB(B0, 1, 0); PG8_SCHED; PG8_LDA(At, 1, 0); PG8_STAGE(PG8_SA(0, 1), a2 + hstep, voffA);
            PG8_WAIT_L(8); PG8_BAR; PG8_WAIT_L(0); PG8_MMA(0, 0, At, B0); PG8_BAR; PG8_SCHED;
            PG8_LDB(B1, 1, 1); PG8_STAGE(PG8_SB(1, 0), b3, voffB);
            PG8_BAR; PG8_WAIT_L(0); PG8_MMA(0, 1, At, B1); PG8_BAR;
            PG8_LDA(At, 1, 1); PG8_STAGE(PG8_SA(1, 0), a3, voffA);
            PG8_BAR; PG8_WAIT_L(0); PG8_MMA(1, 0, At, B0); PG8_BAR; PG8_SCHED;
            PG8_STAGE(PG8_SB(1, 1), b3 + hstep, voffB);
            PG8_WAIT_V(6); PG8_BAR; PG8_MMA(1, 1, At, B1); PG8_BAR;
            }
        }
        if constexpr (ALIGN_EPI) { if (wr == 0) PG8_BAR; }
        if constexpr (!Epi::AFTER_DRAIN) { E(acc, cur, wr, wc, fr, fq); S.done(cur); }
        if (!has_next) break;
#pragma unroll
        for (int a = 0; a < 2; ++a)
#pragma unroll
            for (int b = 0; b < 2; ++b)
#pragma unroll
                for (int m = 0; m < 4; ++m)
#pragma unroll
                    for (int n = 0; n < 2; ++n) acc[a][b][m][n] = (f32x4){0.f, 0.f, 0.f, 0.f};
        cur = nxt; cA = nA; cB = nB; ++ui;
        if constexpr (ALIGN_EPI) { if (wr == 1) PG8_BAR; }
    }
    PG8_WAIT_V(0);
    if constexpr (!ALIGN_EPI) { if (wr == 0) PG8_BAR; }
    PG8_BAR;
    if constexpr (Epi::AFTER_DRAIN) { E.fused(acc, cur, wr, wc, fr, fq, lds, wid, lane); S.done(cur); }
#undef PG8_SA
#undef PG8_SB
#undef PG8_STAGE
#undef PG8_LDA
#undef PG8_LDB
#undef PG8_MMA
#undef PG8_WAIT_V
#undef PG8_WAIT_L
#undef PG8_BAR
#undef PG8_SCHED
}
}

#ifndef PG8_SP2
#define PG8_SP2 true
#endif
#ifndef PG8_ALIGN
#define PG8_ALIGN true
#endif
#ifndef MK_COOP
#define MK_COOP 2
#endif
#if MK_COOP == 1
#include <hip/hip_cooperative_groups.h>
namespace cg = cooperative_groups;
#endif

constexpr int BATCH = 4, SEQ = 8192, D = 1024, M = BATCH * SEQ, DFF = 2816, NQKV = 1536, NH = 16, NKV = 4, HD = 64, CW = 31;
constexpr float EPS = 1e-6f;
constexpr float LOG2E = 1.4426950408889634f;
constexpr float QSCALE = 0.125f * LOG2E;
constexpr int NWAVES = 8;
constexpr int NPHASE = 15;

constexpr size_t MiB = 1u << 20;
constexpr size_t WS_WIN = 2 * MiB, WS_WOUT = 6 * MiB, WS_WQKV = 8 * MiB, WS_WO = 11 * MiB, WS_WGU0 = 13 * MiB, WS_WGU1 = 24 * MiB, WS_WD0 = 35 * MiB, WS_WD1 = 35 * MiB + 5632 * 1024, WS_WEND = 46 * MiB;
constexpr size_t WS_XN = 48 * MiB;
constexpr size_t WS_G0 = 112 * MiB, WS_C0 = 176 * MiB;
constexpr size_t WS_Q = 112 * MiB, WS_K = 176 * MiB, WS_V = 192 * MiB;
constexpr size_t WS_HF = 112 * MiB;
constexpr size_t WS_Y = 288 * MiB;
constexpr size_t WS_END = 416 * MiB;
static_assert(WS_WD1 + (size_t)D * DFF * 2 <= WS_WEND && WS_HF + (size_t)M * DFF * 2 <= WS_Y && WS_Y + (size_t)M * D * 4 <= WS_END, "d_ws map");

constexpr int LDS_BYTES = 147456;
constexpr int LDSCTL_OFF = 131072, MISC_OFF = LDSCTL_OFF + 320;
constexpr size_t WS_CTL = 0, CTL_ZERO_BYTES = 64 * 1024;
constexpr int CW_BAR = 4096;

#define GAS __attribute__((address_space(1)))
#define LAS __attribute__((address_space(3)))
typedef unsigned short bf16;
typedef unsigned v4u __attribute__((ext_vector_type(4)));
typedef unsigned v2u __attribute__((ext_vector_type(2)));
typedef float f32x4 __attribute__((ext_vector_type(4)));
typedef float f32x16 __attribute__((ext_vector_type(16)));
typedef short bf16x8 __attribute__((ext_vector_type(8)));
typedef short s16x4 __attribute__((ext_vector_type(4)));
#define LDS_WAIT() asm volatile("s_waitcnt lgkmcnt(0)" ::: "memory")

__device__ __forceinline__ unsigned pk2(float lo, float hi) { unsigned r; asm volatile("v_cvt_pk_bf16_f32 %0, %1, %2" : "=v"(r) : "v"(lo), "v"(hi)); return r; }
__device__ __forceinline__ float bf2f(unsigned short b) { return __builtin_bit_cast(float, (unsigned)b << 16); }
__device__ __forceinline__ float wave_sum(float v) {
#pragma unroll
    for (int o = 1; o < 64; o <<= 1) v += __shfl_xor(v, o);
    return v;
}

typedef GAS unsigned gu32;
#define RLX_AGENT __ATOMIC_RELAXED, __HIP_MEMORY_SCOPE_AGENT
#define XB_TMO      128
#define XB_XCNT(j)  (256  + 64 * (j))
#define XB_XSUB(j)  (1280 + 64 * (j))
#define XB_XGEN(j)  (2304 + 64 * (j))
#define XB_TOP      3328
#define XB_TOPGEN   3392
#define XCD_BAR_WORDS 3456
#define XB_SPIN_CAP (1u << 18)

__device__ __forceinline__ unsigned xb_ld(unsigned* p)              { return __hip_atomic_load(p, __ATOMIC_RELAXED, __HIP_MEMORY_SCOPE_AGENT); }
__device__ __forceinline__ unsigned xb_add(unsigned* p, unsigned v) { return __hip_atomic_fetch_add(p, v, __ATOMIC_RELAXED, __HIP_MEMORY_SCOPE_AGENT); }
__device__ __forceinline__ unsigned xb_xcc_id() { return (unsigned)__builtin_amdgcn_s_getreg((3 << 11) | 20) & 0xFu; }
#define XB_SPIN(cond, bar) do { unsigned _sp = 0; while (cond) { __builtin_amdgcn_s_sleep(1); \
    if ((++_sp & 255u) == 0u) { if (xb_ld(&(bar)[XB_TMO])) break; if (_sp > XB_SPIN_CAP) { atomicAdd(&(bar)[XB_TMO], 1u); break; } } } } while (0)

struct XcdBarrier {
    unsigned* bar; unsigned x;
    volatile LAS unsigned* st;
};

__device__ __forceinline__ XcdBarrier xcd_barrier_post(unsigned* bar, volatile LAS unsigned* st) {
    XcdBarrier b; b.bar = bar; b.x = xb_xcc_id(); b.st = st;
    if (threadIdx.x == 0) (void)xb_add(&bar[XB_XCNT(b.x)], 1u);
    return b;
}
__device__ __forceinline__ void xcd_barrier_complete(unsigned* bar, unsigned x, unsigned& nloc, unsigned& nx) {
    const unsigned G = gridDim.x * gridDim.y * gridDim.z;
    unsigned sum, cnt, mine, sp = 0u;
    for (;;) {
        sum = 0u; cnt = 0u; mine = 0u;
#pragma unroll
        for (unsigned j = 0; j < 16; ++j) { const unsigned c = xb_ld(&bar[XB_XCNT(j)]); sum += c; cnt += (c > 0u) ? 1u : 0u; mine = (j == x) ? c : mine; }
        if (sum == G) break;
        __builtin_amdgcn_s_sleep(1);
        if ((++sp & 255u) == 0u) { if (xb_ld(&bar[XB_TMO])) break; if (sp > XB_SPIN_CAP) { atomicAdd(&bar[XB_TMO], 1u); break; } }
    }
    nloc = mine > 0u ? mine : 1u; nx = cnt > 0u ? cnt : 1u;
}

__device__ __forceinline__ void xcd_barrier(const XcdBarrier& b) {
    asm volatile("s_waitcnt vmcnt(0)" ::: "memory");
    __syncthreads();
    if (threadIdx.x == 0) {
        unsigned* bar = b.bar;
        __builtin_amdgcn_s_waitcnt(0);
        unsigned nloc = b.st[0], nx = b.st[1];
        if (nloc == 0u) { xcd_barrier_complete(bar, b.x, nloc, nx); b.st[0] = nloc; b.st[1] = nx; }
        const unsigned old = xb_add(&bar[XB_XSUB(b.x)], 1u);
        const unsigned gen = old / nloc;
        if (old + 1u == (gen + 1u) * nloc) {
            __builtin_amdgcn_fence(__ATOMIC_RELEASE, "agent");
            asm volatile("s_waitcnt vmcnt(0)" ::: "memory");
            const unsigned og = xb_add(&bar[XB_TOP], 1u);
            const unsigned tg = og / nx;
            if (og + 1u == (tg + 1u) * nx) xb_add(&bar[XB_TOPGEN], 1u);
            else XB_SPIN(xb_ld(&bar[XB_TOPGEN]) == tg, bar);
            __builtin_amdgcn_fence(__ATOMIC_ACQUIRE, "agent");
            xb_add(&bar[XB_XGEN(b.x)], 1u);
            asm volatile("s_waitcnt vmcnt(0)" ::: "memory");
        } else {
            XB_SPIN(xb_ld(&bar[XB_XGEN(b.x)]) == gen, bar);
            __builtin_amdgcn_fence(__ATOMIC_ACQUIRE, "agent");
            asm volatile("s_waitcnt vmcnt(0)" ::: "memory");
        }
    }
    __syncthreads();
}

struct Frame {
    LAS unsigned char* lds;
    int tid, lane, wave, vcu, G;
};

__device__ __forceinline__ void p0_transpose_item(const float* W, int K, int N, bf16* WT, int k0, int n0, int drow, LAS float* scr, int lane) {
#pragma unroll 8
    for (int i = 0; i < 32; ++i) { const int kk = 2 * i + (lane >> 5); scr[kk * 33 + (lane & 31)] = W[(size_t)(k0 + kk) * N + n0 + (lane & 31)]; }
    LDS_WAIT(); asm volatile("" ::: "memory");
    const int c = lane & 7;
#pragma unroll
    for (int j = 0; j < 4; ++j) { const int n = (lane >> 3) + 8 * j; const LAS float* s = scr + (8 * c) * 33 + n;
        v4u o; o.x = pk2(s[0 * 33], s[1 * 33]); o.y = pk2(s[2 * 33], s[3 * 33]); o.z = pk2(s[4 * 33], s[5 * 33]); o.w = pk2(s[6 * 33], s[7 * 33]);
        *(v4u*)(WT + (size_t)(drow + n) * K + k0 + 8 * c) = o; }
    LDS_WAIT(); asm volatile("" ::: "memory");
}
__device__ __forceinline__ int gate_row(int n0, int half) { const int hsel = n0 >= half ? 1 : 0; const int c = n0 - hsel * half; return 256 * (c >> 7) + 128 * hsel + (c & 127); }


__device__ __forceinline__ void rms_row_to_bf16(const float* xrow, bf16* orow, const f32x4 (&g)[4], int lane) {
    const f32x4* xr = (const f32x4*)xrow + lane;
    f32x4 v[4]; float s = 0.f;
#pragma unroll
    for (int j = 0; j < 4; ++j) { v[j] = xr[64 * j]; s += (v[j].x * v[j].x + v[j].y * v[j].y) + (v[j].z * v[j].z + v[j].w * v[j].w); }
    const float rstd = rsqrtf(wave_sum(s) * (1.f / D) + EPS);
    v2u* o8 = (v2u*)orow + lane;
#pragma unroll
    for (int j = 0; j < 4; ++j) { v2u w; w.x = pk2(v[j].x * rstd * g[j].x, v[j].y * rstd * g[j].y); w.y = pk2(v[j].z * rstd * g[j].z, v[j].w * rstd * g[j].w); o8[64 * j] = w; }
}

__device__ __forceinline__ void thin_phase(const Frame& F, const float* Y, const float* base, float* out, bf16* XN, const float* gpost, const float* gpre) {
    const int gw = F.vcu * NWAVES + F.wave, NGW = F.G * NWAVES, lane = F.lane;
    f32x4 gp[4], gq[4];
#pragma unroll
    for (int j = 0; j < 4; ++j) { gp[j] = ((const f32x4*)gpost)[lane + 64 * j]; gq[j] = gpre ? ((const f32x4*)gpre)[lane + 64 * j] : (f32x4){0.f, 0.f, 0.f, 0.f}; }
    for (int m = gw; m < M; m += NGW) {
        const f32x4* yr = (const f32x4*)(Y + (size_t)m * D) + lane; const f32x4* br = (const f32x4*)(base + (size_t)m * D) + lane;
        f32x4 y[4], h[4]; float s = 0.f;
#pragma unroll
        for (int j = 0; j < 4; ++j) { y[j] = yr[64 * j]; h[j] = br[64 * j]; }
#pragma unroll
        for (int j = 0; j < 4; ++j) s += (y[j].x * y[j].x + y[j].y * y[j].y) + (y[j].z * y[j].z + y[j].w * y[j].w);
        const float rstd = rsqrtf(wave_sum(s) * (1.f / D) + EPS);
        f32x4* orow = (f32x4*)(out + (size_t)m * D) + lane; float s2 = 0.f;
#pragma unroll
        for (int j = 0; j < 4; ++j) { h[j] = h[j] + y[j] * rstd * gp[j]; orow[64 * j] = h[j]; s2 += (h[j].x * h[j].x + h[j].y * h[j].y) + (h[j].z * h[j].z + h[j].w * h[j].w); }
        if (gpre) {
            const float r2 = rsqrtf(wave_sum(s2) * (1.f / D) + EPS);
            v2u* o8 = (v2u*)(XN + (size_t)m * D) + lane;
#pragma unroll
            for (int j = 0; j < 4; ++j) { v2u w; w.x = pk2(h[j].x * r2 * gq[j].x, h[j].y * r2 * gq[j].y); w.y = pk2(h[j].z * r2 * gq[j].z, h[j].w * r2 * gq[j].w); o8[64 * j] = w; }
        }
    }
}

constexpr int CV_SEG = 128;
constexpr int CV_TILE = 0;
constexpr int CV_LNG = 65536, CV_LNB = 65536 + 4096;
template <int C4>
__device__ __forceinline__ void conv_chunk(float (&win0)[32], float (&win1)[32], const float (&w0)[CW], const float (&w1)[CW], unsigned (&buf)[8], const GAS bf16*& gp, bool more, float bias0, float bias1,
                                           LAS unsigned char* lds, bf16* orow, int tid, int wave, int lane) {
    typedef float f32x2 __attribute__((ext_vector_type(2)));
    LAS f32x2* tile = (LAS f32x2*)(lds + CV_TILE + (C4 & 1) * 32768);
#pragma unroll
    for (int kk = 0; kk < 8; ++kk) {
        const int k = C4 * 8 + kk;
        win0[k] = __builtin_bit_cast(float, buf[kk] << 16); win1[k] = __builtin_bit_cast(float, buf[kk] & 0xffff0000u);
        if (more) { asm volatile("" : "+v"(gp)); buf[kk] = *(const GAS unsigned*)gp; gp += D; }
        float a0 = bias0, a1 = bias1;
#pragma unroll
        for (int j = 0; j < CW; ++j) { a0 = __builtin_fmaf(w0[j], win0[(2 + k + j) & 31], a0); a1 = __builtin_fmaf(w1[j], win1[(2 + k + j) & 31], a1); }
        tile[kk * 512 + tid] = (f32x2){a0, a1};
    }
    __syncthreads();
    {
        const LAS f32x4* tr = (const LAS f32x4*)(lds + CV_TILE + (C4 & 1) * 32768 + wave * 4096) + lane;
        const LAS f32x4* lg = (const LAS f32x4*)(lds + CV_LNG) + lane; const LAS f32x4* lb = (const LAS f32x4*)(lds + CV_LNB) + lane;
        f32x4 v[4]; float sm = 0.f, q = 0.f;
#pragma unroll
        for (int j = 0; j < 4; ++j) { v[j] = tr[64 * j]; sm += (v[j].x + v[j].y) + (v[j].z + v[j].w); q += (v[j].x * v[j].x + v[j].y * v[j].y) + (v[j].z * v[j].z + v[j].w * v[j].w); }
        sm = wave_sum(sm); q = wave_sum(q);
        const float mean = sm * (1.f / D); const float rstd = rsqrtf(fmaxf(q * (1.f / D) - mean * mean, 0.f) + EPS);
        v2u* o8 = (v2u*)(orow + (size_t)wave * D) + lane;
#pragma unroll
        for (int j = 0; j < 4; ++j) { const f32x4 g = lg[64 * j], bb = lb[64 * j]; f32x4 y = (v[j] - mean) * rstd * g + bb;
            y.x = y.x * sigmoid_f(y.x); y.y = y.y * sigmoid_f(y.y); y.z = y.z * sigmoid_f(y.z); y.w = y.w * sigmoid_f(y.w);
            v2u w; w.x = pk2(y.x, y.y); w.y = pk2(y.z, y.w); o8[64 * j] = w; }
    }
}

__device__ __forceinline__ void conv_phase(const Frame& F, const bf16* G0, bf16* C0, const float* dww, const float* dwb, const float* lng, const float* lnb) {
    const int tid = F.tid, c = 2 * tid;
    for (int i = tid; i < D; i += NWAVES * 64) { ((LAS float*)(F.lds + CV_LNG))[i] = lng[i]; ((LAS float*)(F.lds + CV_LNB))[i] = lnb[i]; }
    float w0[CW], w1[CW];
    { const GAS float* wp = (const GAS float*)(dww + c);
#pragma unroll
      for (int j = 0; j < CW; ++j) { asm volatile("" : "+v"(wp)); typedef float f32x2g __attribute__((ext_vector_type(2))); const f32x2g w = *(const GAS f32x2g*)wp; w0[j] = w.x; w1[j] = w.y; wp += D; } }
    const float2 bb = *(const float2*)(dwb + c);
    __syncthreads();
    for (int seg = F.vcu; seg < M / CV_SEG; seg += F.G) {
        const int t0 = seg * CV_SEG; const bool first = (t0 % SEQ) == 0;
        float win0[32], win1[32];
        win0[0] = win0[1] = win1[0] = win1[1] = 0.f;
        const GAS bf16* gp = (const GAS bf16*)(G0 + ((long)t0 - 30) * D + c);
#pragma unroll
        for (int s = 2; s < 32; ++s) { unsigned v = 0u; if (!first) { asm volatile("" : "+v"(gp)); v = *(const GAS unsigned*)gp; } gp += D;
            win0[s] = __builtin_bit_cast(float, v << 16); win1[s] = __builtin_bit_cast(float, v & 0xffff0000u); }
        unsigned buf[8];
#pragma unroll
        for (int kk = 0; kk < 8; ++kk) { asm volatile("" : "+v"(gp)); buf[kk] = *(const GAS unsigned*)gp; gp += D; }
        for (int blk = 0; blk < CV_SEG / 32; ++blk) {
            const int r0 = t0 + blk * 32; const bool notlast = blk + 1 < CV_SEG / 32;
            conv_chunk<0>(win0, win1, w0, w1, buf, gp, true, bb.x, bb.y, F.lds, C0 + (size_t)r0 * D, tid, F.wave, F.lane);
            conv_chunk<1>(win0, win1, w0, w1, buf, gp, true, bb.x, bb.y, F.lds, C0 + (size_t)(r0 + 8) * D, tid, F.wave, F.lane);
            conv_chunk<2>(win0, win1, w0, w1, buf, gp, true, bb.x, bb.y, F.lds, C0 + (size_t)(r0 + 16) * D, tid, F.wave, F.lane);
            conv_chunk<3>(win0, win1, w0, w1, buf, gp, notlast, bb.x, bb.y, F.lds, C0 + (size_t)(r0 + 24) * D, tid, F.wave, F.lane);
        }
    }
    __syncthreads();
}

constexpr int AT_KS = 0;
constexpr int AT_VT = 32768;
constexpr int AT_VLD = 260;
constexpr int AT_BIAS = AT_VT + 64 * AT_VLD * 2 + 512;
constexpr int AT_SINK = AT_BIAS + 16 * 128 * 4;
static_assert(AT_BIAS % 16 == 0 && AT_SINK + 64 <= 131072, "attention LDS map");
__device__ __forceinline__ int t5_bucket(int d) {
    if (d < 16) return d;
    int b = 16;
    b += (d >= 19) + (d >= 21) + (d >= 24) + (d >= 27) + (d >= 31) + (d >= 35) + (d >= 40) + (d >= 46) + (d >= 52) + (d >= 59) + (d >= 67) + (d >= 77) + (d >= 87) + (d >= 99) + (d >= 113);
    return b;
}
__device__ __forceinline__ void attn_phase(const Frame& F, const bf16* Q, const bf16* Kg, const bf16* Vg, bf16* O, const float* sinks, const float* rel_bias) {
    LAS unsigned char* lds = F.lds;
    LAS float* bias2 = (LAS float*)(lds + AT_BIAS); LAS float* sink2 = (LAS float*)(lds + AT_SINK);
    const int tid = F.tid, lane = F.lane, wave = F.wave, r32 = lane & 31, hi = lane >> 5;
    for (int idx = tid; idx < 16 * 128; idx += NWAVES * 64) { const int h = idx >> 7, d = idx & 127; bias2[idx] = rel_bias[t5_bucket(d) * NH + h] * LOG2E; }
    if (tid < 16) sink2[tid] = sinks[tid] * LOG2E;
    __syncthreads();
    constexpr int NUNIT = BATCH * NKV * (SEQ / 128);
    const int upw = (NUNIT + F.G - 1) / F.G;
    for (int ui = 0; ui < upw; ++ui) {
        const int unit = F.vcu * upw + ui; if (unit >= NUNIT) break;
        const int n = unit & 63, kv = (unit >> 6) & 3, b = unit >> 8;
        const long rowbase = (long)b * SEQ + n * 128 - 128;
#pragma unroll
        for (int i = 0; i < 4; ++i) { const int q = tid + 512 * i, row = q >> 3, ch = q & 7; const bool ok = (n > 0) || (row >= 128);
            v4u kq = (v4u){0u, 0u, 0u, 0u}, vq = (v4u){0u, 0u, 0u, 0u};
            if (ok) { kq = *(const v4u*)(Kg + (size_t)(rowbase + row) * 256 + kv * 64 + ch * 8); vq = *(const v4u*)(Vg + (size_t)(rowbase + row) * 256 + kv * 64 + ch * 8); }
            *(LAS v4u*)(lds + AT_KS + row * 128 + ((ch ^ ((row >> 1) & 7)) << 4)) = kq;
            LAS unsigned short* vt = (LAS unsigned short*)(lds + AT_VT) + (ch * 8) * AT_VLD + row;
            vt[0 * AT_VLD] = (unsigned short)(vq.x & 0xffffu); vt[1 * AT_VLD] = (unsigned short)(vq.x >> 16);
            vt[2 * AT_VLD] = (unsigned short)(vq.y & 0xffffu); vt[3 * AT_VLD] = (unsigned short)(vq.y >> 16);
            vt[4 * AT_VLD] = (unsigned short)(vq.z & 0xffffu); vt[5 * AT_VLD] = (unsigned short)(vq.z >> 16);
            vt[6 * AT_VLD] = (unsigned short)(vq.w & 0xffffu); vt[7 * AT_VLD] = (unsigned short)(vq.w >> 16); }
        __syncthreads();
        const int g = wave >> 1, head = kv * 4 + g;
        const float snk = sink2[head];
        for (int sb = 0; sb < 2; ++sb) {
            const int qi = (wave & 1) * 2 + sb;
            const size_t rowq = (size_t)b * SEQ + n * 128 + qi * 32 + r32;
            bf16x8 qf[4];
#pragma unroll
            for (int kk = 0; kk < 4; ++kk) qf[kk] = *(const bf16x8*)(Q + rowq * D + head * HD + kk * 16 + hi * 8);
            f32x16 s[5];
#pragma unroll
            for (int t = 0; t < 5; ++t) { const int krow = (qi + t) * 32 + r32; const LAS unsigned char* kb = lds + AT_KS + krow * 128; const int sw = (krow >> 1) & 7;
                f32x16 a = {};
#pragma unroll
                for (int kk = 0; kk < 4; ++kk) { const bf16x8 kf = *(const LAS bf16x8*)(kb + (((2 * kk + hi) ^ sw) << 4)); a = __builtin_amdgcn_mfma_f32_32x32x16_bf16(kf, qf[kk], a, 0, 0, 0); }
                s[t] = a; }
            const int iq = qi * 32 + r32;
            float mx = snk;
#pragma unroll
            for (int t = 0; t < 5; ++t)
#pragma unroll
                for (int r = 0; r < 16; ++r) { const int sidx = (qi + t) * 32 + (r & 3) + 8 * (r >> 2) + 4 * hi; const int dist = iq + 128 - sidx;
                    const bool ok = (dist >= 0) && (dist < 128) && ((n > 0) || (sidx >= 128));
                    const float v = ok ? s[t][r] + bias2[head * 128 + (dist & 127)] : -INFINITY;
                    s[t][r] = v; mx = fmaxf(mx, v); }
            mx = fmaxf(mx, __shfl_xor(mx, 32));
            float l = 0.f;
#pragma unroll
            for (int t = 0; t < 5; ++t)
#pragma unroll
                for (int r = 0; r < 16; ++r) { const float p = __builtin_amdgcn_exp2f(s[t][r] - mx); s[t][r] = p; l += p; }
            l += __shfl_xor(l, 32);
            l += __builtin_amdgcn_exp2f(snk - mx);
            f32x16 o[2]; o[0] = (f32x16){}; o[1] = (f32x16){};
#pragma unroll
            for (int t = 0; t < 5; ++t)
#pragma unroll
                for (int ks = 0; ks < 2; ++ks) {
                    v4u pw; pw.x = pk2(s[t][8 * ks + 0], s[t][8 * ks + 1]); pw.y = pk2(s[t][8 * ks + 2], s[t][8 * ks + 3]); pw.z = pk2(s[t][8 * ks + 4], s[t][8 * ks + 5]); pw.w = pk2(s[t][8 * ks + 6], s[t][8 * ks + 7]);
                    const bf16x8 pb = __builtin_bit_cast(bf16x8, pw);
#pragma unroll
                    for (int db = 0; db < 2; ++db) { const LAS unsigned short* vp = (const LAS unsigned short*)(lds + AT_VT) + (db * 32 + r32) * AT_VLD + (qi + t) * 32 + 16 * ks + 4 * hi;
                        const s16x4 lo = *(const LAS s16x4*)vp, hh = *(const LAS s16x4*)(vp + 8);
                        const bf16x8 va = (bf16x8){lo[0], lo[1], lo[2], lo[3], hh[0], hh[1], hh[2], hh[3]};
                        o[db] = __builtin_amdgcn_mfma_f32_32x32x16_bf16(va, pb, o[db], 0, 0, 0); } }
            const float inv = 1.0f / l;
            bf16* orow = O + rowq * D + head * HD;
#pragma unroll
            for (int db = 0; db < 2; ++db)
#pragma unroll
                for (int gq = 0; gq < 4; ++gq) { v2u w; w.x = pk2(o[db][4 * gq + 0] * inv, o[db][4 * gq + 1] * inv); w.y = pk2(o[db][4 * gq + 2] * inv, o[db][4 * gq + 3] * inv);
                    *(v2u*)(orow + db * 32 + 8 * gq + 4 * hi) = w; }
        }
        __syncthreads();
    }
}

struct Args { const float* in[21]; float* out; unsigned char* ws; int ph_lo, ph_hi; };
static_assert(sizeof(Args) == 21 * 8 + 8 + 8 + 8, "Args has no padding");

__global__ void __launch_bounds__(NWAVES * 64, 2) mk_fwd(Args args) {
    extern __shared__ __attribute__((aligned(16))) unsigned char lds_raw[];
    Frame F;
    F.lds = (LAS unsigned char*)lds_raw;
    F.tid = threadIdx.x; F.lane = F.tid & 63; F.wave = __builtin_amdgcn_readfirstlane(F.tid >> 6);
    F.G = gridDim.x; { const int bx = blockIdx.x; F.vcu = (F.G % 8 == 0) ? (bx % 8) * (F.G / 8) + bx / 8 : bx; }
    unsigned char* ws = args.ws;
    const float* x = args.in[0];
    const float* mix_pre_g = args.in[1]; const float* mix_post_g = args.in[2]; const float* ffn_pre_g = args.in[3]; const float* ffn_post_g = args.in[4];
    float* out = args.out;
    bf16* XN = (bf16*)(ws + WS_XN); bf16* G0 = (bf16*)(ws + WS_G0); bf16* C0 = (bf16*)(ws + WS_C0); bf16* HF = (bf16*)(ws + WS_HF);
    bf16* Qb = (bf16*)(ws + WS_Q); bf16* Kb = (bf16*)(ws + WS_K); bf16* Vb = (bf16*)(ws + WS_V); float* Y = (float*)(ws + WS_Y);
#if MK_COOP == 1
    cg::grid_group grid = cg::this_grid();
#elif MK_COOP == 2
    for (int u = F.tid; u < (LDS_BYTES - LDSCTL_OFF) / 4; u += NWAVES * 64) ((LAS unsigned*)(F.lds + LDSCTL_OFF))[u] = 0u;
    __syncthreads();
    XcdBarrier bar = xcd_barrier_post((unsigned*)(args.ws + WS_CTL) + CW_BAR, (volatile LAS unsigned*)(F.lds + MISC_OFF) + 8);
#endif
#ifndef PH_MASK
#define PH_MASK 0x7fff
#endif
#define PH_ON(k) ((PH_MASK >> (k)) & 1)
    for (int ph = args.ph_lo; ph < args.ph_hi; ++ph) {
        { int t_ = threadIdx.x; asm volatile("" : "+v"(t_)); F.tid = t_; F.lane = t_ & 63; F.wave = __builtin_amdgcn_readfirstlane(t_ >> 6); }
        { long z_ = 0; asm volatile("" : "+s"(z_)); ws = args.ws + z_; out = args.out + z_; x = args.in[0] + z_; }
        XN = (bf16*)(ws + WS_XN); G0 = (bf16*)(ws + WS_G0); C0 = (bf16*)(ws + WS_C0); HF = (bf16*)(ws + WS_HF);
        Qb = (bf16*)(ws + WS_Q); Kb = (bf16*)(ws + WS_K); Vb = (bf16*)(ws + WS_V); Y = (float*)(ws + WS_Y);
        if (ph == 0 && PH_ON(0)) {
            LAS float* scr = (LAS float*)(F.lds + F.wave * 16384);
            const int gw = F.vcu * NWAVES + F.wave, NGW = F.G * NWAVES;
            int it0 = 0;
#define P0_JOB(Wp, WTp, Kd, Nd, halfd) do { const float* W_ = (Wp); bf16* WT_ = (bf16*)(WTp); const int K_ = (Kd), N_ = (Nd), half_ = (halfd); const int nblk = N_ / 32, nitems = (K_ / 64) * nblk; \
                const int first = ((gw - it0) % NGW + NGW) % NGW; \
                for (int it = first; it < nitems; it += NGW) { const int kb = it / nblk, nb = it % nblk, n0 = 32 * nb; const int drow = half_ ? gate_row(n0, half_) : n0; \
                    p0_transpose_item(W_, K_, N_, WT_, 64 * kb, n0, drow, scr, F.lane); } \
                it0 += nitems; } while (0)
            P0_JOB(args.in[5], ws + WS_WIN, D, 2 * D, D);
            P0_JOB(args.in[11], ws + WS_WOUT, D, D, 0);
            P0_JOB(args.in[13], ws + WS_WQKV, D, NQKV, 0);
            P0_JOB(args.in[15], ws + WS_WO, D, D, 0);
            P0_JOB(args.in[19], ws + WS_WGU0, D, 2 * DFF, DFF);
            P0_JOB(args.in[19] + (size_t)D * 2 * DFF, ws + WS_WGU1, D, 2 * DFF, DFF);
            P0_JOB(args.in[20], ws + WS_WD0, DFF, D, 0);
            P0_JOB(args.in[20] + (size_t)DFF * D, ws + WS_WD1, DFF, D, 0);
#undef P0_JOB
            f32x4 g[4];
#pragma unroll
            for (int j = 0; j < 4; ++j) g[j] = ((const f32x4*)mix_pre_g)[F.lane + 64 * j];
            for (int m = gw; m < M; m += NGW) rms_row_to_bf16(x + (size_t)m * D, XN + (size_t)m * D, g, F.lane);
        } else if ((ph == 1 || ph == 5 || ph == 12) && PH_ON(1)) {
            if (ph == 1) { pg8::Gemm gm{XN, (const bf16*)(ws + WS_WIN), M, 2 * D, D}; pg8::StaticOrder S; S.init(M, 2 * D, F.G, (int)blockIdx.x);
                pg8::EpiGate<0> E{G0, D, args.in[6], D};
                pg8::gemm_phase<pg8::EpiGate<0>, pg8::StaticOrder, PG8_ALIGN, PG8_SP2>(F.lds, gm, S, E, F.tid);
            } else { pg8::Gemm gm{XN, (const bf16*)(ws + (ph == 5 ? WS_WGU0 : WS_WGU1)), M, 2 * DFF, D}; pg8::StaticOrder S; S.init(M, 2 * DFF, F.G, (int)blockIdx.x);
                pg8::EpiGate<1> E{HF, DFF, nullptr, DFF};
                pg8::gemm_phase<pg8::EpiGate<1>, pg8::StaticOrder, PG8_ALIGN, PG8_SP2>(F.lds, gm, S, E, F.tid); }
        } else if (ph == 2 && PH_ON(2)) {
            conv_phase(F, G0, C0, args.in[7], args.in[8], args.in[9], args.in[10]);
        } else if ((ph == 3 || ph == 6 || ph == 10 || ph == 13) && PH_ON(3)) {
            pg8::Gemm gm; const float* bias;
            if (ph == 3) { gm = pg8::Gemm{C0, (const bf16*)(ws + WS_WOUT), M, D, D}; bias = args.in[12]; }
            else if (ph == 10) { gm = pg8::Gemm{Qb, (const bf16*)(ws + WS_WO), M, D, D}; bias = args.in[16]; }
            else { gm = pg8::Gemm{HF, (const bf16*)(ws + (ph == 6 ? WS_WD0 : WS_WD1)), M, D, DFF}; bias = nullptr; }
            pg8::StaticOrder S; S.init(M, D, F.G, (int)blockIdx.x);
            pg8::EpiF32 E{Y, D, bias};
            pg8::gemm_phase<pg8::EpiF32, pg8::StaticOrder, PG8_ALIGN, PG8_SP2>(F.lds, gm, S, E, F.tid);
        } else if (ph == 4 && PH_ON(4)) { thin_phase(F, Y, x, out, XN, mix_post_g, ffn_pre_g);
        } else if (ph == 7 && PH_ON(4)) { thin_phase(F, Y, out, out, XN, ffn_post_g, mix_pre_g + D);
        } else if (ph == 11 && PH_ON(4)) { thin_phase(F, Y, out, out, XN, mix_post_g + D, ffn_pre_g + D);
        } else if (ph == 14 && PH_ON(4)) { thin_phase(F, Y, out, out, XN, ffn_post_g + D, nullptr);
        } else if (ph == 8 && PH_ON(8)) {
            pg8::Gemm gm{XN, (const bf16*)(ws + WS_WQKV), M, NQKV, D}; pg8::StaticOrder S; S.init(M, NQKV, F.G, (int)blockIdx.x);
            pg8::EpiQKV E{Qb, Kb, Vb, args.in[14], QSCALE};
            pg8::gemm_phase<pg8::EpiQKV, pg8::StaticOrder, PG8_ALIGN, PG8_SP2>(F.lds, gm, S, E, F.tid);
        } else if (ph == 9 && PH_ON(9)) {
            attn_phase(F, Qb, Kb, Vb, Qb, args.in[17], args.in[18]);
        }
#if MK_COOP == 1
        if (ph + 1 < args.ph_hi) grid.sync();
#elif MK_COOP == 2
        if (ph + 1 < args.ph_hi) xcd_barrier(bar);
#endif
    }
}

extern "C" void kernel_launch(void* const* d_in, const int* in_sizes, int n_in, void* d_out, int out_size, void* d_ws, size_t ws_size, hipStream_t stream) {
    static int grid = 0;
    if (grid == 0) {
        if (n_in != 21 || in_sizes[0] != M * D || out_size != M * D || ws_size < WS_END) { fprintf(stderr, "kernel_launch: unexpected shapes (n_in %d, in0 %d, out %d, ws %zu)\n", n_in, n_in > 0 ? in_sizes[0] : -1, out_size, ws_size); grid = -1; return; }
        int dev = 0, cus = 0, per_cu = 0;
        if (hipGetDevice(&dev) != hipSuccess || hipDeviceGetAttribute(&cus, hipDeviceAttributeMultiprocessorCount, dev) != hipSuccess) { grid = -1; return; }
        if (hipFuncSetAttribute((const void*)mk_fwd, hipFuncAttributeMaxDynamicSharedMemorySize, LDS_BYTES) != hipSuccess) { fprintf(stderr, "kernel_launch: hipFuncSetAttribute failed\n"); grid = -1; return; }
        if (hipOccupancyMaxActiveBlocksPerMultiprocessor(&per_cu, (const void*)mk_fwd, NWAVES * 64, LDS_BYTES) != hipSuccess || per_cu < 1) { fprintf(stderr, "kernel_launch: occupancy query says %d\n", per_cu); per_cu = 1; }
        (void)hipGetLastError();
        grid = cus * 1;
    }
    if (grid < 0) return;
    Args a{};
    for (int i = 0; i < 21; ++i) a.in[i] = (const float*)d_in[i];
    a.out = (float*)d_out; a.ws = (unsigned char*)d_ws;
#if MK_COOP == 2
    if (hipMemsetAsync((char*)d_ws + WS_CTL, 0, CTL_ZERO_BYTES, stream) != hipSuccess) { fprintf(stderr, "kernel_launch: hipMemsetAsync failed\n"); return; }
    a.ph_lo = 0; a.ph_hi = NPHASE;
    hipLaunchKernelGGL(mk_fwd, dim3(grid), dim3(NWAVES * 64), LDS_BYTES, stream, a);
#elif MK_COOP == 1
    a.ph_lo = 0; a.ph_hi = NPHASE;
    void* kargs[] = {&a};
    hipError_t e = hipLaunchCooperativeKernel((const void*)mk_fwd, dim3(grid), dim3(NWAVES * 64), kargs, LDS_BYTES, stream);
    if (e != hipSuccess) fprintf(stderr, "kernel_launch: cooperative launch failed: %s (grid %d)\n", hipGetErrorString(e), grid);
#else
    for (int ph = 0; ph < NPHASE; ++ph) { a.ph_lo = ph; a.ph_hi = ph + 1; hipLaunchKernelGGL(mk_fwd, dim3(grid), dim3(NWAVES * 64), LDS_BYTES, stream, a); }
#endif
}
```

```cpp
#include <hip/hip_runtime.h>
#include <cstdio>
#include <cstdint>
__device__ __forceinline__ float sigmoid_f(float x) { return __builtin_amdgcn_rcpf(1.0f + __builtin_amdgcn_exp2f(-1.4426950408889634f * x)); }
namespace pg8 {
#define PG8_LAS __attribute__((address_space(3)))
typedef unsigned short bf16_t;
typedef short bf16x8 __attribute__((ext_vector_type(8)));
typedef float f32x4 __attribute__((ext_vector_type(4)));
typedef unsigned u32x4 __attribute__((ext_vector_type(4)));
constexpr int BM = 256, BK = 64, HALF = 128, HTB = HALF * BK * 2  , STAGE_BYTES = 8 * HTB, NXCD = 8, WGM = 8;

__host__ __device__ __forceinline__ int lds_byte(int r, int c) { const int st = (r >> 4) * 2 + (c >> 5), rr = r & 15, cc = c & 31, ob = rr * 64 + cc * 2; return st * 1024 + (ob ^ (((ob >> 9) & 1) << 5)); }
__host__ __device__ __forceinline__ void stage_rc(int b, int& R, int& C) { const int st = b / 1024, sb = b % 1024, swz = sb ^ (((sb >> 9) & 1) << 5); R = (st >> 1) * 16 + swz / 64; C = (st & 1) * 32 + (swz % 64) / 2; }
__host__ __device__ __forceinline__ int perm32(int rho) { const int n = rho >> 4, i = rho & 15; return 8 * (i >> 2) + 4 * n + (i & 3); }

struct Unit { int pm, pn; };
struct Gemm { const bf16_t* A; const bf16_t* Bt; int M, N, K; int a_tiled = 0, b_tiled = 0; };

struct StaticOrder {
    int nM, nN, nwg, G, c; int pmx = 0;
    __host__ __device__ void init(int M, int N, int G_, int c_) { nM = M / BM; nN = N / BM; nwg = nM * nN; G = G_; c = c_; }
    __host__ __device__ bool next(int i, Unit& u) const {
        const long L = (long)i * G + c; if (L >= nwg) return false;
        int wgid = (int)L; { const int q = nwg / NXCD, r = nwg % NXCD, xcd = wgid % NXCD, off = wgid / NXCD; wgid = (xcd < r ? xcd * (q + 1) : r * (q + 1) + (xcd - r) * q) + off; }
        const int nig = WGM * nN, gid = wgid / nig, fm = gid * WGM, gsz = (nM - fm) < WGM ? (nM - fm) : WGM;
        u.pm = (fm + ((wgid % nig) % gsz)) ^ pmx; u.pn = (wgid % nig) / gsz; return true;
    }
    __device__ __forceinline__ void a_ready(const Unit&) const {}
    __device__ __forceinline__ void done(const Unit&) const {}
};


__device__ __forceinline__ unsigned cvt_pk_bf16(float lo, float hi) { unsigned r; asm volatile("v_cvt_pk_bf16_f32 %0, %1, %2" : "=v"(r) : "v"(lo), "v"(hi)); return r; }

struct EpiF32 {
    static constexpr bool PERM = false, AFTER_DRAIN = false;
    float* C; int ldc; const float* bias;
    __device__ __forceinline__ void operator()(const f32x4 (&acc)[2][2][4][2], const Unit& u, int wr, int wc, int fr, int fq) const {
        const int row0 = u.pm * BM + wr * 64 + fr, col0 = u.pn * BM + wc * 32 + 4 * fq;
        f32x4 bv[2][2];
#pragma unroll
        for (int bj = 0; bj < 2; ++bj)
#pragma unroll
            for (int n = 0; n < 2; ++n) bv[bj][n] = bias ? *(const f32x4*)(bias + col0 + bj * HALF + n * 16) : (f32x4){0.f, 0.f, 0.f, 0.f};
#pragma unroll
        for (int ai = 0; ai < 2; ++ai)
#pragma unroll
            for (int m = 0; m < 4; ++m) { float* rowp = C + (size_t)(row0 + ai * HALF + m * 16) * ldc + col0;
#pragma unroll
                for (int bj = 0; bj < 2; ++bj)
#pragma unroll
                    for (int n = 0; n < 2; ++n) *(f32x4*)(rowp + bj * HALF + n * 16) = acc[ai][bj][m][n] + bv[bj][n]; }
    }
};
template <int ACT> struct EpiGate {
    static constexpr bool PERM = true, AFTER_DRAIN = false;
    bf16_t* O; int ldc; const float* bias; int half_cols; int tiled;
    __device__ __forceinline__ void operator()(const f32x4 (&acc)[2][2][4][2], const Unit& u, int wr, int wc, int fr, int fq) const {
        const int row0 = u.pm * BM + wr * 64 + fr, oc0 = u.pn * HALF + wc * 32 + 8 * fq;
        const size_t tbase = tiled ? ((size_t)u.pm * (ldc >> 6) + (oc0 >> 6)) * (BM * BK) + (oc0 & 63) : 0;
        f32x4 bv[2][2];
#pragma unroll
        for (int bj = 0; bj < 2; ++bj)
#pragma unroll
            for (int n = 0; n < 2; ++n) bv[bj][n] = bias ? *(const f32x4*)(bias + bj * half_cols + oc0 + 4 * n) : (f32x4){0.f, 0.f, 0.f, 0.f};
#pragma unroll
        for (int ai = 0; ai < 2; ++ai)
#pragma unroll
            for (int m = 0; m < 4; ++m) { bf16_t* rowp = tiled ? O + tbase + (size_t)(wr * 64 + fr + ai * HALF + m * 16) * BK : O + (size_t)(row0 + ai * HALF + m * 16) * ldc + oc0;
                float r[8];
#pragma unroll
                for (int n = 0; n < 2; ++n) { const f32x4 a = acc[ai][0][m][n] + bv[0][n], b = acc[ai][1][m][n] + bv[1][n];
#pragma unroll
                    for (int j = 0; j < 4; ++j) r[4 * n + j] = (ACT == 0) ? a[j] * sigmoid_f(b[j]) : a[j] * sigmoid_f(a[j]) * b[j]; }
                u32x4 w; w.x = cvt_pk_bf16(r[0], r[1]); w.y = cvt_pk_bf16(r[2], r[3]); w.z = cvt_pk_bf16(r[4], r[5]); w.w = cvt_pk_bf16(r[6], r[7]);
                *(u32x4*)rowp = w; asm volatile("" ::: "memory"); }
    }
};
struct EpiQKV {
    static constexpr bool PERM = true, AFTER_DRAIN = false;
    bf16_t* Q; bf16_t* Kp; bf16_t* Vp; const float* bias; float qscale;
    __device__ __forceinline__ void operator()(const f32x4 (&acc)[2][2][4][2], const Unit& u, int wr, int wc, int fr, int fq) const {
        const int row0 = u.pm * BM + wr * 64 + fr; const int colt = u.pn * BM;
        bf16_t* base; int ldc, c0; float sc = 1.f;
        if (colt < 1024) { base = Q; ldc = 1024; c0 = colt; sc = qscale; } else if (colt < 1280) { base = Kp; ldc = 256; c0 = 0; } else { base = Vp; ldc = 256; c0 = 0; }
        const int col0 = c0 + wc * 32 + 8 * fq, bcol0 = colt + wc * 32 + 8 * fq;
        f32x4 bv[2][2];
#pragma unroll
        for (int bj = 0; bj < 2; ++bj)
#pragma unroll
            for (int n = 0; n < 2; ++n) bv[bj][n] = *(const f32x4*)(bias + bcol0 + bj * HALF + 4 * n);
#pragma unroll
        for (int ai = 0; ai < 2; ++ai)
#pragma unroll
            for (int m = 0; m < 4; ++m) { bf16_t* rowp = base + (size_t)(row0 + ai * HALF + m * 16) * ldc + col0;
#pragma unroll
                for (int bj = 0; bj < 2; ++bj) { const f32x4 v0 = (acc[ai][bj][m][0] + bv[bj][0]) * sc, v1 = (acc[ai][bj][m][1] + bv[bj][1]) * sc;
                    u32x4 w; w.x = cvt_pk_bf16(v0[0], v0[1]); w.y = cvt_pk_bf16(v0[2], v0[3]); w.z = cvt_pk_bf16(v1[0], v1[1]); w.w = cvt_pk_bf16(v1[2], v1[3]);
                    *(u32x4*)(rowp + bj * HALF) = w; } }
    }
};

template <class Epi, class Sched, bool ALIGN_EPI = false, bool SP2 = false>
__device__ __forceinline__ void gemm_phase(PG8_LAS unsigned char* lds, const Gemm g, const Sched& S, const Epi& E, const int tid) {
    const int wid = __builtin_amdgcn_readfirstlane(tid >> 6), lane = tid & 63, wr = wid >> 2, wc = wid & 3, fr = lane & 15, fq = lane >> 4;
    const int K = g.K, nt = K / BK;
    unsigned voffA[2], voffB[2];
#pragma unroll
    for (int i = 0; i < 2; ++i) { int R, C; stage_rc(tid * 16 + i * 8192, R, C); const int Rb = Epi::PERM ? ((R & ~31) + perm32(R & 31)) : R;
        voffA[i] = (unsigned)(R * (g.a_tiled ? BK : K) + C) * 2u; voffB[i] = (unsigned)(Rb * (g.b_tiled ? BK : K) + C) * 2u; }
    const size_t kstepA = g.a_tiled ? (size_t)(BM * BK * 2) : (size_t)(BK * 2), kstepB = g.b_tiled ? (size_t)(BM * BK * 2) : (size_t)(BK * 2);
    const size_t hstepA = g.a_tiled ? (size_t)(HALF * BK * 2) : (size_t)HALF * K * 2, hstepB = g.b_tiled ? (size_t)(HALF * BK * 2) : (size_t)HALF * K * 2;
    const size_t tstep = (size_t)BM * K * 2;
    const unsigned ldsw = (unsigned)wid * 1024u;
    const int aoff = lds_byte(wr * 64 + fr, fq * 8), boff = lds_byte(wc * 32 + fr, fq * 8);
#define PG8_SA(b, h) (((b) * 2 + (h)) * HTB)
#define PG8_SB(b, h) ((4 + (b) * 2 + (h)) * HTB)
#define PG8_STAGE(bufoff, gbase, voff) do { _Pragma("unroll") for (int _i = 0; _i < 2; ++_i) \
        __builtin_amdgcn_global_load_lds((const unsigned*)((const char*)(gbase) + (voff)[_i]), (PG8_LAS unsigned*)(lds + (bufoff) + ldsw + _i * 8192), 16, 0, 0); } while (0)
#define PG8_LDA(dst, b, h) do { _Pragma("unroll") for (int m = 0; m < 4; ++m) _Pragma("unroll") for (int k = 0; k < 2; ++k) dst[m][k] = *(const PG8_LAS bf16x8*)(lds + PG8_SA(b, h) + aoff + m * 2048 + k * 1024); } while (0)
#define PG8_LDB(dst, b, h) do { _Pragma("unroll") for (int n = 0; n < 2; ++n) _Pragma("unroll") for (int k = 0; k < 2; ++k) dst[n][k] = *(const PG8_LAS bf16x8*)(lds + PG8_SB(b, h) + boff + n * 2048 + k * 1024); } while (0)
#define PG8_MMA(ai, bj, At, Bt) do { __builtin_amdgcn_s_setprio(1); _Pragma("unroll") for (int m = 0; m < 4; ++m) _Pragma("unroll") for (int n = 0; n < 2; ++n) _Pragma("unroll") for (int k = 0; k < 2; ++k) \
        acc[ai][bj][m][n] = __builtin_amdgcn_mfma_f32_16x16x32_bf16(Bt[n][k], At[m][k], acc[ai][bj][m][n], 0, 0, 0); __builtin_amdgcn_s_setprio(0); } while (0)
#define PG8_WAIT_V(n) asm volatile("s_waitcnt vmcnt(" #n ")" ::: "memory")
#define PG8_WAIT_L(n) asm volatile("s_waitcnt lgkmcnt(" #n ")" ::: "memory")
#define PG8_BAR __builtin_amdgcn_s_barrier()
#define PG8_SCHED __builtin_amdgcn_sched_barrier(0)
    Unit cur, nxt; int ui = 0;
    if (!S.next(0, cur)) return;
    f32x4 acc[2][2][4][2];
#pragma unroll
    for (int a = 0; a < 2; ++a)
#pragma unroll
        for (int b = 0; b < 2; ++b)
#pragma unroll
            for (int m = 0; m < 4; ++m)
#pragma unroll
                for (int n = 0; n < 2; ++n) acc[a][b][m][n] = (f32x4){0.f, 0.f, 0.f, 0.f};
    bf16x8 At[4][2], B0[2][2], B1[2][2];
    const char* cA = (const char*)g.A + (size_t)cur.pm * tstep; const char* cB = (const char*)g.Bt + (size_t)cur.pn * tstep;
    S.a_ready(cur);
    if constexpr (SP2) {
        PG8_STAGE(PG8_SB(0, 0), cB, voffB); PG8_STAGE(PG8_SB(0, 1), cB + hstepB, voffB); PG8_STAGE(PG8_SA(0, 0), cA, voffA); PG8_STAGE(PG8_SA(0, 1), cA + hstepA, voffA);
        if (wr == 1) PG8_BAR;
        PG8_WAIT_V(2); PG8_BAR;
        PG8_STAGE(PG8_SB(1, 0), cB + kstepB, voffB); PG8_STAGE(PG8_SA(1, 0), cA + kstepA, voffA); PG8_STAGE(PG8_SB(1, 1), cB + hstepB + kstepB, voffB);
        PG8_WAIT_V(6); PG8_BAR;
    } else {
        PG8_STAGE(PG8_SB(0, 0), cB, voffB); PG8_STAGE(PG8_SA(0, 0), cA, voffA); PG8_STAGE(PG8_SB(0, 1), cB + hstepB, voffB); PG8_STAGE(PG8_SA(0, 1), cA + hstepA, voffA);
        if (wr == 1) PG8_BAR;
        PG8_WAIT_V(4); PG8_BAR;
        PG8_STAGE(PG8_SB(1, 0), cB + kstepB, voffB); PG8_STAGE(PG8_SA(1, 0), cA + kstepA, voffA); PG8_STAGE(PG8_SB(1, 1), cB + hstepB + kstepB, voffB);
        PG8_WAIT_V(6); PG8_BAR;
    }
    for (;;) {
        const bool has_next = S.next(ui + 1, nxt);
        const char* nA = has_next ? (const char*)g.A + (size_t)nxt.pm * tstep : cA; const char* nB = has_next ? (const char*)g.Bt + (size_t)nxt.pn * tstep : cB;
        for (int t = 0; t < nt; t += 2) {
            const bool last = (t == nt - 2);
            const char* a1 = cA + (size_t)(t + 1) * kstepA;
            const char* a2 = last ? nA : cA + (size_t)(t + 2) * kstepA; const char* b2 = last ? nB : cB + (size_t)(t + 2) * kstepB;
            const char* a3 = a2 + kstepA; const char* b3 = b2 + kstepB;
            if (last && has_next) S.a_ready(nxt);
            if constexpr (SP2) {
            PG8_LDB(B0, 0, 0); PG8_LDB(B1, 0, 1); PG8_SCHED; PG8_LDA(At, 0, 0); PG8_STAGE(PG8_SA(1, 1), a1 + hstepA, voffA);
            PG8_WAIT_V(8); PG8_WAIT_L(0); PG8_BAR; PG8_MMA(0, 0, At, B0); PG8_MMA(0, 1, At, B1); PG8_BAR; PG8_SCHED;
            PG8_LDA(At, 0, 1); PG8_STAGE(PG8_SB(0, 0), b2, voffB); PG8_STAGE(PG8_SB(0, 1), b2 + hstepB, voffB); PG8_STAGE(PG8_SA(0, 0), a2, voffA);
            PG8_WAIT_V(8); PG8_WAIT_L(0); PG8_BAR; PG8_MMA(1, 0, At, B0); PG8_MMA(1, 1, At, B1); PG8_BAR; PG8_SCHED;
            PG8_LDB(B0, 1, 0); PG8_LDB(B1, 1, 1); PG8_SCHED; PG8_LDA(At, 1, 0); PG8_STAGE(PG8_SA(0, 1), a2 + hstepA, voffA);
            PG8_WAIT_V(8); PG8_WAIT_L(0); PG8_BAR; PG8_MMA(0, 0, At, B0); PG8_MMA(0, 1, At, B1); PG8_BAR; PG8_SCHED;
            PG8_LDA(At, 1, 1); PG8_STAGE(PG8_SB(1, 0), b3, voffB); PG8_STAGE(PG8_SB(1, 1), b3 + hstepB, voffB); PG8_STAGE(PG8_SA(1, 0), a3, voffA);
            PG8_WAIT_V(8); PG8_WAIT_L(0); PG8_BAR; PG8_MMA(1, 0, At, B0); PG8_MMA(1, 1, At, B1); PG8_BAR; PG8_SCHED;
            } else {
            PG8_LDB(B0, 0, 0); PG8_SCHED; PG8_LDA(At, 0, 0); PG8_STAGE(PG8_SA(1, 1), a1 + hstepA, voffA);
            PG8_WAIT_L(8); PG8_BAR; PG8_WAIT_L(0); PG8_MMA(0, 0, At, B0); PG8_BAR; PG8_SCHED;
            PG8_LDB(B1, 0, 1); PG8_STAGE(PG8_SB(0, 0), b2, voffB);
            PG8_BAR; PG8_WAIT_L(0); PG8_MMA(0, 1, At, B1); PG8_BAR;
            PG8_LDA(At, 0, 1); PG8_STAGE(PG8_SA(0, 0), a2, voffA);
            PG8_BAR; PG8_WAIT_L(0); PG8_MMA(1, 0, At, B0); PG8_BAR; PG8_SCHED;
            PG8_STAGE(PG8_SB(0, 1), b2 + hstepB, voffB);
            PG8_WAIT_V(6); PG8_BAR; PG8_MMA(1, 1, At, B1); PG8_BAR;
            PG8_LDB(B0, 1, 0); PG8_SCHED; PG8_LDA(At, 1, 0); PG8_STAGE(PG8_SA(0, 1), a2 + hstepA, voffA);
            PG8_WAIT_L(8); PG8_BAR; PG8_WAIT_L(0); PG8_MMA(0, 0, At, B0); PG8_BAR; PG8_SCHED;
            PG8_LDB(B1, 1, 1); PG8_STAGE(PG8_SB(1, 0), b3, voffB);
            PG8_BAR; PG8_WAIT_L(0); PG8_MMA(0, 1, At, B1); PG8_BAR;
            PG8_LDA(At, 1, 1); PG8_STAGE(PG8_SA(1, 0), a3, voffA);
            PG8_BAR; PG8_WAIT_L(0); PG8_MMA(1, 0, At, B0); PG8_BAR; PG8_SCHED;
            PG8_STAGE(PG8_SB(1, 1), b3 + hstepB, voffB);
            PG8_WAIT_V(6); PG8_BAR; PG8_MMA(1, 1, At, B1); PG8_BAR;
            }
        }
        if constexpr (ALIGN_EPI) { if (wr == 0) PG8_BAR; }
        if constexpr (!Epi::AFTER_DRAIN) { E(acc, cur, wr, wc, fr, fq); S.done(cur); }
        if (!has_next) break;
#pragma unroll
        for (int a = 0; a < 2; ++a)
#pragma unroll
            for (int b = 0; b < 2; ++b)
#pragma unroll
                for (int m = 0; m < 4; ++m)
#pragma unroll
                    for (int n = 0; n < 2; ++n) acc[a][b][m][n] = (f32x4){0.f, 0.f, 0.f, 0.f};
        cur = nxt; cA = nA; cB = nB; ++ui;
        if constexpr (ALIGN_EPI) { if (wr == 1) PG8_BAR; }
    }
    PG8_WAIT_V(0);
    if constexpr (!ALIGN_EPI) { if (wr == 0) PG8_BAR; }
    PG8_BAR;
    if constexpr (Epi::AFTER_DRAIN) { E.fused(acc, cur, wr, wc, fr, fq, lds, wid, lane); S.done(cur); }
#undef PG8_SA
#undef PG8_SB
#undef PG8_STAGE
#undef PG8_LDA
#undef PG8_LDB
#undef PG8_MMA
#undef PG8_WAIT_V
#undef PG8_WAIT_L
#undef PG8_BAR
#undef PG8_SCHED
}
}

#ifndef PG8_SP2
#define PG8_SP2 true
#endif
#ifndef PG8_ALIGN
#define PG8_ALIGN true
#endif
#ifndef MK_COOP
#define MK_COOP 2
#endif
#if MK_COOP == 1
#include <hip/hip_cooperative_groups.h>
namespace cg = cooperative_groups;
#endif

constexpr int BATCH = 4, SEQ = 8192, D = 1024, M = BATCH * SEQ, DFF = 2816, NQKV = 1536, NH = 16, NKV = 4, HD = 64, CW = 31;
constexpr float EPS = 1e-6f;
constexpr float LOG2E = 1.4426950408889634f;
constexpr float QSCALE = 0.125f * LOG2E;
constexpr int NWAVES = 8;
constexpr int NPHASE = 15;

constexpr size_t MiB = 1u << 20;
constexpr size_t WS_WIN = 2 * MiB, WS_WOUT = 6 * MiB, WS_WQKV = 8 * MiB, WS_WO = 11 * MiB, WS_WGU0 = 13 * MiB, WS_WGU1 = 24 * MiB, WS_WD0 = 35 * MiB, WS_WD1 = 35 * MiB + 5632 * 1024, WS_WEND = 46 * MiB;
constexpr size_t WS_XN = 48 * MiB;
constexpr size_t WS_G0 = 112 * MiB, WS_C0 = 176 * MiB;
constexpr size_t WS_Q = 112 * MiB, WS_K = 176 * MiB, WS_V = 192 * MiB;
constexpr size_t WS_HF = 112 * MiB;
constexpr size_t WS_Y = 288 * MiB;
constexpr size_t WS_END = 416 * MiB;
static_assert(WS_WD1 + (size_t)D * DFF * 2 <= WS_WEND && WS_HF + (size_t)M * DFF * 2 <= WS_Y && WS_Y + (size_t)M * D * 4 <= WS_END, "d_ws map");

constexpr int LDS_BYTES = 147456;
constexpr int LDSCTL_OFF = 131072, MISC_OFF = LDSCTL_OFF + 320;
constexpr size_t WS_CTL = 0, CTL_ZERO_BYTES = 64 * 1024;
constexpr int CW_BAR = 4096;

#define GAS __attribute__((address_space(1)))
#define LAS __attribute__((address_space(3)))
typedef unsigned short bf16;
typedef unsigned v4u __attribute__((ext_vector_type(4)));
typedef unsigned v2u __attribute__((ext_vector_type(2)));
typedef float f32x4 __attribute__((ext_vector_type(4)));
typedef float f32x16 __attribute__((ext_vector_type(16)));
typedef short bf16x8 __attribute__((ext_vector_type(8)));
typedef short s16x4 __attribute__((ext_vector_type(4)));
#define LDS_WAIT() asm volatile("s_waitcnt lgkmcnt(0)" ::: "memory")

__device__ __forceinline__ unsigned pk2(float lo, float hi) { unsigned r; asm volatile("v_cvt_pk_bf16_f32 %0, %1, %2" : "=v"(r) : "v"(lo), "v"(hi)); return r; }
__device__ __forceinline__ float bf2f(unsigned short b) { return __builtin_bit_cast(float, (unsigned)b << 16); }
__device__ __forceinline__ float wave_sum(float v) {
#pragma unroll
    for (int o = 1; o < 64; o <<= 1) v += __shfl_xor(v, o);
    return v;
}

typedef GAS unsigned gu32;
#define RLX_AGENT __ATOMIC_RELAXED, __HIP_MEMORY_SCOPE_AGENT
#define XB_TMO      128
#define XB_XCNT(j)  (256  + 64 * (j))
#define XB_XSUB(j)  (1280 + 64 * (j))
#define XB_XGEN(j)  (2304 + 64 * (j))
#define XB_TOP      3328
#define XB_TOPGEN   3392
#define XCD_BAR_WORDS 3456
#define XB_SPIN_CAP (1u << 18)

__device__ __forceinline__ unsigned xb_ld(unsigned* p)              { return __hip_atomic_load(p, __ATOMIC_RELAXED, __HIP_MEMORY_SCOPE_AGENT); }
__device__ __forceinline__ unsigned xb_add(unsigned* p, unsigned v) { return __hip_atomic_fetch_add(p, v, __ATOMIC_RELAXED, __HIP_MEMORY_SCOPE_AGENT); }
__device__ __forceinline__ unsigned xb_xcc_id() { return (unsigned)__builtin_amdgcn_s_getreg((3 << 11) | 20) & 0xFu; }
#define XB_SPIN(cond, bar) do { unsigned _sp = 0; while (cond) { __builtin_amdgcn_s_sleep(1); \
    if ((++_sp & 255u) == 0u) { if (xb_ld(&(bar)[XB_TMO])) break; if (_sp > XB_SPIN_CAP) { atomicAdd(&(bar)[XB_TMO], 1u); break; } } } } while (0)

struct XcdBarrier {
    unsigned* bar; unsigned x;
    volatile LAS unsigned* st;
};

__device__ __forceinline__ XcdBarrier xcd_barrier_post(unsigned* bar, volatile LAS unsigned* st) {
    XcdBarrier b; b.bar = bar; b.x = xb_xcc_id(); b.st = st;
    if (threadIdx.x == 0) (void)xb_add(&bar[XB_XCNT(b.x)], 1u);
    return b;
}
__device__ __forceinline__ void xcd_barrier_complete(unsigned* bar, unsigned x, unsigned& nloc, unsigned& nx) {
    const unsigned G = gridDim.x * gridDim.y * gridDim.z;
    unsigned sum, cnt, mine, sp = 0u;
    for (;;) {
        sum = 0u; cnt = 0u; mine = 0u;
#pragma unroll
        for (unsigned j = 0; j < 16; ++j) { const unsigned c = xb_ld(&bar[XB_XCNT(j)]); sum += c; cnt += (c > 0u) ? 1u : 0u; mine = (j == x) ? c : mine; }
        if (sum == G) break;
        __builtin_amdgcn_s_sleep(1);
        if ((++sp & 255u) == 0u) { if (xb_ld(&bar[XB_TMO])) break; if (sp > XB_SPIN_CAP) { atomicAdd(&bar[XB_TMO], 1u); break; } }
    }
    nloc = mine > 0u ? mine : 1u; nx = cnt > 0u ? cnt : 1u;
}

__device__ __forceinline__ void xcd_barrier(const XcdBarrier& b) {
    asm volatile("s_waitcnt vmcnt(0)" ::: "memory");
    __syncthreads();
    if (threadIdx.x == 0) {
        unsigned* bar = b.bar;
        __builtin_amdgcn_s_waitcnt(0);
        unsigned nloc = b.st[0], nx = b.st[1];
        if (nloc == 0u) { xcd_barrier_complete(bar, b.x, nloc, nx); b.st[0] = nloc; b.st[1] = nx; }
        const unsigned old = xb_add(&bar[XB_XSUB(b.x)], 1u);
        const unsigned gen = old / nloc;
        if (old + 1u == (gen + 1u) * nloc) {
            __builtin_amdgcn_fence(__ATOMIC_RELEASE, "agent");
            asm volatile("s_waitcnt vmcnt(0)" ::: "memory");
            const unsigned og = xb_add(&bar[XB_TOP], 1u);
            const unsigned tg = og / nx;
            if (og + 1u == (tg + 1u) * nx) xb_add(&bar[XB_TOPGEN], 1u);
            else XB_SPIN(xb_ld(&bar[XB_TOPGEN]) == tg, bar);
            __builtin_amdgcn_fence(__ATOMIC_ACQUIRE, "agent");
            xb_add(&bar[XB_XGEN(b.x)], 1u);
            asm volatile("s_waitcnt vmcnt(0)" ::: "memory");
        } else {
            XB_SPIN(xb_ld(&bar[XB_XGEN(b.x)]) == gen, bar);
            __builtin_amdgcn_fence(__ATOMIC_ACQUIRE, "agent");
            asm volatile("s_waitcnt vmcnt(0)" ::: "memory");
        }
    }
    __syncthreads();
}

struct Frame {
    LAS unsigned char* lds;
    int tid, lane, wave, vcu, G;
};

__device__ __forceinline__ void p0_transpose_item(const float* W, int K, int N, bf16* WT, int k0, int n0, int drow, LAS float* scr, int lane) {
#pragma unroll 8
    for (int i = 0; i < 32; ++i) { const int kk = 2 * i + (lane >> 5); scr[kk * 33 + (lane & 31)] = W[(size_t)(k0 + kk) * N + n0 + (lane & 31)]; }
    LDS_WAIT(); asm volatile("" ::: "memory");
    const int c = lane & 7;
#pragma unroll
    for (int j = 0; j < 4; ++j) { const int n = (lane >> 3) + 8 * j; const LAS float* s = scr + (8 * c) * 33 + n;
        v4u o; o.x = pk2(s[0 * 33], s[1 * 33]); o.y = pk2(s[2 * 33], s[3 * 33]); o.z = pk2(s[4 * 33], s[5 * 33]); o.w = pk2(s[6 * 33], s[7 * 33]);
        *(v4u*)(WT + (size_t)(drow + n) * K + k0 + 8 * c) = o; }
    LDS_WAIT(); asm volatile("" ::: "memory");
}
__device__ __forceinline__ int gate_row(int n0, int half) { const int hsel = n0 >= half ? 1 : 0; const int c = n0 - hsel * half; return 256 * (c >> 7) + 128 * hsel + (c & 127); }


__device__ __forceinline__ void rms_row_to_bf16(const float* xrow, bf16* orow, const f32x4 (&g)[4], int lane) {
    const f32x4* xr = (const f32x4*)xrow + lane;
    f32x4 v[4]; float s = 0.f;
#pragma unroll
    for (int j = 0; j < 4; ++j) { v[j] = xr[64 * j]; s += (v[j].x * v[j].x + v[j].y * v[j].y) + (v[j].z * v[j].z + v[j].w * v[j].w); }
    const float rstd = rsqrtf(wave_sum(s) * (1.f / D) + EPS);
    v2u* o8 = (v2u*)orow + lane;
#pragma unroll
    for (int j = 0; j < 4; ++j) { v2u w; w.x = pk2(v[j].x * rstd * g[j].x, v[j].y * rstd * g[j].y); w.y = pk2(v[j].z * rstd * g[j].z, v[j].w * rstd * g[j].w); o8[64 * j] = w; }
}

__device__ __forceinline__ void thin_phase(const Frame& F, const float* Y, const float* base, float* out, bf16* XN, const float* gpost, const float* gpre) {
    const int gw = F.vcu * NWAVES + F.wave, NGW = F.G * NWAVES, lane = F.lane;
    f32x4 gp[4], gq[4];
#pragma unroll
    for (int j = 0; j < 4; ++j) { gp[j] = ((const f32x4*)gpost)[lane + 64 * j]; gq[j] = gpre ? ((const f32x4*)gpre)[lane + 64 * j] : (f32x4){0.f, 0.f, 0.f, 0.f}; }
    for (int m = gw; m < M; m += NGW) {
        const f32x4* yr = (const f32x4*)(Y + (size_t)m * D) + lane; const f32x4* br = (const f32x4*)(base + (size_t)m * D) + lane;
        f32x4 y[4], h[4]; float s = 0.f;
#pragma unroll
        for (int j = 0; j < 4; ++j) { y[j] = yr[64 * j]; h[j] = br[64 * j]; }
#pragma unroll
        for (int j = 0; j < 4; ++j) s += (y[j].x * y[j].x + y[j].y * y[j].y) + (y[j].z * y[j].z + y[j].w * y[j].w);
        const float rstd = rsqrtf(wave_sum(s) * (1.f / D) + EPS);
        f32x4* orow = (f32x4*)(out + (size_t)m * D) + lane; float s2 = 0.f;
#pragma unroll
        for (int j = 0; j < 4; ++j) { h[j] = h[j] + y[j] * rstd * gp[j]; orow[64 * j] = h[j]; s2 += (h[j].x * h[j].x + h[j].y * h[j].y) + (h[j].z * h[j].z + h[j].w * h[j].w); }
        if (gpre) {
            const float r2 = rsqrtf(wave_sum(s2) * (1.f / D) + EPS);
            v2u* o8 = (v2u*)(XN + (size_t)m * D) + lane;
#pragma unroll
            for (int j = 0; j < 4; ++j) { v2u w; w.x = pk2(h[j].x * r2 * gq[j].x, h[j].y * r2 * gq[j].y); w.y = pk2(h[j].z * r2 * gq[j].z, h[j].w * r2 * gq[j].w); o8[64 * j] = w; }
        }
    }
}

constexpr int CV_SEG = 128;
constexpr int CV_TILE = 0;
constexpr int CV_LNG = 65536, CV_LNB = 65536 + 4096;
template <int C4>
__device__ __forceinline__ void conv_chunk(float (&win0)[32], float (&win1)[32], const float (&w0)[CW], const float (&w1)[CW], unsigned (&buf)[8], const GAS bf16*& gp, bool more, float bias0, float bias1,
                                           LAS unsigned char* lds, bf16* orow, int tid, int wave, int lane) {
    typedef float f32x2 __attribute__((ext_vector_type(2)));
    LAS f32x2* tile = (LAS f32x2*)(lds + CV_TILE + (C4 & 1) * 32768);
#pragma unroll
    for (int kk = 0; kk < 8; ++kk) {
        const int k = C4 * 8 + kk;
        win0[k] = __builtin_bit_cast(float, buf[kk] << 16); win1[k] = __builtin_bit_cast(float, buf[kk] & 0xffff0000u);
        if (more) { asm volatile("" : "+v"(gp)); buf[kk] = *(const GAS unsigned*)gp; gp += D; }
        float a0 = bias0, a1 = bias1;
#pragma unroll
        for (int j = 0; j < CW; ++j) { a0 = __builtin_fmaf(w0[j], win0[(2 + k + j) & 31], a0); a1 = __builtin_fmaf(w1[j], win1[(2 + k + j) & 31], a1); }
        tile[kk * 512 + tid] = (f32x2){a0, a1};
    }
    __syncthreads();
    {
        const LAS f32x4* tr = (const LAS f32x4*)(lds + CV_TILE + (C4 & 1) * 32768 + wave * 4096) + lane;
        const LAS f32x4* lg = (const LAS f32x4*)(lds + CV_LNG) + lane; const LAS f32x4* lb = (const LAS f32x4*)(lds + CV_LNB) + lane;
        f32x4 v[4]; float sm = 0.f, q = 0.f;
#pragma unroll
        for (int j = 0; j < 4; ++j) { v[j] = tr[64 * j]; sm += (v[j].x + v[j].y) + (v[j].z + v[j].w); q += (v[j].x * v[j].x + v[j].y * v[j].y) + (v[j].z * v[j].z + v[j].w * v[j].w); }
        sm = wave_sum(sm); q = wave_sum(q);
        const float mean = sm * (1.f / D); const float rstd = rsqrtf(fmaxf(q * (1.f / D) - mean * mean, 0.f) + EPS);
        v2u* o8 = (v2u*)(orow + (size_t)wave * D) + lane;
#pragma unroll
        for (int j = 0; j < 4; ++j) { const f32x4 g = lg[64 * j], bb = lb[64 * j]; f32x4 y = (v[j] - mean) * rstd * g + bb;
            y.x = y.x * sigmoid_f(y.x); y.y = y.y * sigmoid_f(y.y); y.z = y.z * sigmoid_f(y.z); y.w = y.w * sigmoid_f(y.w);
            v2u w; w.x = pk2(y.x, y.y); w.y = pk2(y.z, y.w); o8[64 * j] = w; }
    }
}

__device__ __forceinline__ void conv_phase(const Frame& F, const bf16* G0, bf16* C0, const float* dww, const float* dwb, const float* lng, const float* lnb) {
    const int tid = F.tid, c = 2 * tid;
    for (int i = tid; i < D; i += NWAVES * 64) { ((LAS float*)(F.lds + CV_LNG))[i] = lng[i]; ((LAS float*)(F.lds + CV_LNB))[i] = lnb[i]; }
    float w0[CW], w1[CW];
    { const GAS float* wp = (const GAS float*)(dww + c);
#pragma unroll
      for (int j = 0; j < CW; ++j) { asm volatile("" : "+v"(wp)); typedef float f32x2g __attribute__((ext_vector_type(2))); const f32x2g w = *(const GAS f32x2g*)wp; w0[j] = w.x; w1[j] = w.y; wp += D; } }
    const float2 bb = *(const float2*)(dwb + c);
    __syncthreads();
    for (int seg = F.vcu; seg < M / CV_SEG; seg += F.G) {
        const int t0 = seg * CV_SEG; const bool first = (t0 % SEQ) == 0;
        float win0[32], win1[32];
        win0[0] = win0[1] = win1[0] = win1[1] = 0.f;
        const GAS bf16* gp = (const GAS bf16*)(G0 + ((long)t0 - 30) * D + c);
#pragma unroll
        for (int s = 2; s < 32; ++s) { unsigned v = 0u; if (!first) { asm volatile("" : "+v"(gp)); v = *(const GAS unsigned*)gp; } gp += D;
            win0[s] = __builtin_bit_cast(float, v << 16); win1[s] = __builtin_bit_cast(float, v & 0xffff0000u); }
        unsigned buf[8];
#pragma unroll
        for (int kk = 0; kk < 8; ++kk) { asm volatile("" : "+v"(gp)); buf[kk] = *(const GAS unsigned*)gp; gp += D; }
        for (int blk = 0; blk < CV_SEG / 32; ++blk) {
            const int r0 = t0 + blk * 32; const bool notlast = blk + 1 < CV_SEG / 32;
            conv_chunk<0>(win0, win1, w0, w1, buf, gp, true, bb.x, bb.y, F.lds, C0 + (size_t)r0 * D, tid, F.wave, F.lane);
            conv_chunk<1>(win0, win1, w0, w1, buf, gp, true, bb.x, bb.y, F.lds, C0 + (size_t)(r0 + 8) * D, tid, F.wave, F.lane);
            conv_chunk<2>(win0, win1, w0, w1, buf, gp, true, bb.x, bb.y, F.lds, C0 + (size_t)(r0 + 16) * D, tid, F.wave, F.lane);
            conv_chunk<3>(win0, win1, w0, w1, buf, gp, notlast, bb.x, bb.y, F.lds, C0 + (size_t)(r0 + 24) * D, tid, F.wave, F.lane);
        }
    }
    __syncthreads();
}

constexpr int AT_KS = 0;
constexpr int AT_VT = 32768;
constexpr int AT_VLD = 260;
constexpr int AT_BIAS = AT_VT + 64 * AT_VLD * 2 + 512;
constexpr int AT_SINK = AT_BIAS + 16 * 128 * 4;
static_assert(AT_BIAS % 16 == 0 && AT_SINK + 64 <= 131072, "attention LDS map");
__device__ __forceinline__ int t5_bucket(int d) {
    if (d < 16) return d;
    int b = 16;
    b += (d >= 19) + (d >= 21) + (d >= 24) + (d >= 27) + (d >= 31) + (d >= 35) + (d >= 40) + (d >= 46) + (d >= 52) + (d >= 59) + (d >= 67) + (d >= 77) + (d >= 87) + (d >= 99) + (d >= 113);
    return b;
}
__device__ __forceinline__ void attn_phase(const Frame& F, const bf16* Q, const bf16* Kg, const bf16* Vg, bf16* O, const float* sinks, const float* rel_bias) {
    LAS unsigned char* lds = F.lds;
    LAS float* bias2 = (LAS float*)(lds + AT_BIAS); LAS float* sink2 = (LAS float*)(lds + AT_SINK);
    const int tid = F.tid, lane = F.lane, wave = F.wave, r32 = lane & 31, hi = lane >> 5;
    for (int idx = tid; idx < 16 * 128; idx += NWAVES * 64) { const int h = idx >> 7, d = idx & 127; bias2[idx] = rel_bias[t5_bucket(d) * NH + h] * LOG2E; }
    if (tid < 16) sink2[tid] = sinks[tid] * LOG2E;
    __syncthreads();
    constexpr int NUNIT = BATCH * NKV * (SEQ / 128);
    const int upw = (NUNIT + F.G - 1) / F.G;
    for (int ui = 0; ui < upw; ++ui) {
        const int unit = F.vcu * upw + ui; if (unit >= NUNIT) break;
        const int n = unit & 63, kv = (unit >> 6) & 3, b = unit >> 8;
        const long rowbase = (long)b * SEQ + n * 128 - 128;
#pragma unroll
        for (int i = 0; i < 4; ++i) { const int q = tid + 512 * i, row = q >> 3, ch = q & 7; const bool ok = (n > 0) || (row >= 128);
            v4u kq = (v4u){0u, 0u, 0u, 0u}, vq = (v4u){0u, 0u, 0u, 0u};
            if (ok) { kq = *(const v4u*)(Kg + (size_t)(rowbase + row) * 256 + kv * 64 + ch * 8); vq = *(const v4u*)(Vg + (size_t)(rowbase + row) * 256 + kv * 64 + ch * 8); }
            *(LAS v4u*)(lds + AT_KS + row * 128 + ((ch ^ ((row >> 1) & 7)) << 4)) = kq;
            LAS unsigned short* vt = (LAS unsigned short*)(lds + AT_VT) + (ch * 8) * AT_VLD + row;
            vt[0 * AT_VLD] = (unsigned short)(vq.x & 0xffffu); vt[1 * AT_VLD] = (unsigned short)(vq.x >> 16);
            vt[2 * AT_VLD] = (unsigned short)(vq.y & 0xffffu); vt[3 * AT_VLD] = (unsigned short)(vq.y >> 16);
            vt[4 * AT_VLD] = (unsigned short)(vq.z & 0xffffu); vt[5 * AT_VLD] = (unsigned short)(vq.z >> 16);
            vt[6 * AT_VLD] = (unsigned short)(vq.w & 0xffffu); vt[7 * AT_VLD] = (unsigned short)(vq.w >> 16); }
        __syncthreads();
        const int g = wave >> 1, head = kv * 4 + g;
        const float snk = sink2[head];
        for (int sb = 0; sb < 2; ++sb) {
            const int qi = (wave & 1) * 2 + sb;
            const size_t rowq = (size_t)b * SEQ + n * 128 + qi * 32 + r32;
            bf16x8 qf[4];
#pragma unroll
            for (int kk = 0; kk < 4; ++kk) qf[kk] = *(const bf16x8*)(Q + rowq * D + head * HD + kk * 16 + hi * 8);
            f32x16 s[5];
#pragma unroll
            for (int t = 0; t < 5; ++t) { const int krow = (qi + t) * 32 + r32; const LAS unsigned char* kb = lds + AT_KS + krow * 128; const int sw = (krow >> 1) & 7;
                f32x16 a = {};
#pragma unroll
                for (int kk = 0; kk < 4; ++kk) { const bf16x8 kf = *(const LAS bf16x8*)(kb + (((2 * kk + hi) ^ sw) << 4)); a = __builtin_amdgcn_mfma_f32_32x32x16_bf16(kf, qf[kk], a, 0, 0, 0); }
                s[t] = a; }
            const int iq = qi * 32 + r32;
            float mx = snk;
#pragma unroll
            for (int t = 0; t < 5; ++t)
#pragma unroll
                for (int r = 0; r < 16; ++r) { const int sidx = (qi + t) * 32 + (r & 3) + 8 * (r >> 2) + 4 * hi; const int dist = iq + 128 - sidx;
                    const bool ok = (dist >= 0) && (dist < 128) && ((n > 0) || (sidx >= 128));
                    const float v = ok ? s[t][r] + bias2[head * 128 + (dist & 127)] : -INFINITY;
                    s[t][r] = v; mx = fmaxf(mx, v); }
            mx = fmaxf(mx, __shfl_xor(mx, 32));
            float l = 0.f;
#pragma unroll
            for (int t = 0; t < 5; ++t)
#pragma unroll
                for (int r = 0; r < 16; ++r) { const float p = __builtin_amdgcn_exp2f(s[t][r] - mx); s[t][r] = p; l += p; }
            l += __shfl_xor(l, 32);
            l += __builtin_amdgcn_exp2f(snk - mx);
            f32x16 o[2]; o[0] = (f32x16){}; o[1] = (f32x16){};
#pragma unroll
            for (int t = 0; t < 5; ++t)
#pragma unroll
                for (int ks = 0; ks < 2; ++ks) {
                    v4u pw; pw.x = pk2(s[t][8 * ks + 0], s[t][8 * ks + 1]); pw.y = pk2(s[t][8 * ks + 2], s[t][8 * ks + 3]); pw.z = pk2(s[t][8 * ks + 4], s[t][8 * ks + 5]); pw.w = pk2(s[t][8 * ks + 6], s[t][8 * ks + 7]);
                    const bf16x8 pb = __builtin_bit_cast(bf16x8, pw);
#pragma unroll
                    for (int db = 0; db < 2; ++db) { const LAS unsigned short* vp = (const LAS unsigned short*)(lds + AT_VT) + (db * 32 + r32) * AT_VLD + (qi + t) * 32 + 16 * ks + 4 * hi;
                        const s16x4 lo = *(const LAS s16x4*)vp, hh = *(const LAS s16x4*)(vp + 8);
                        const bf16x8 va = (bf16x8){lo[0], lo[1], lo[2], lo[3], hh[0], hh[1], hh[2], hh[3]};
                        o[db] = __builtin_amdgcn_mfma_f32_32x32x16_bf16(va, pb, o[db], 0, 0, 0); } }
            const float inv = 1.0f / l;
            bf16* orow = O + rowq * D + head * HD;
#pragma unroll
            for (int db = 0; db < 2; ++db)
#pragma unroll
                for (int gq = 0; gq < 4; ++gq) { v2u w; w.x = pk2(o[db][4 * gq + 0] * inv, o[db][4 * gq + 1] * inv); w.y = pk2(o[db][4 * gq + 2] * inv, o[db][4 * gq + 3] * inv);
                    *(v2u*)(orow + db * 32 + 8 * gq + 4 * hi) = w; }
        }
        __syncthreads();
    }
}

struct Args { const float* in[21]; float* out; unsigned char* ws; int ph_lo, ph_hi; };
static_assert(sizeof(Args) == 21 * 8 + 8 + 8 + 8, "Args has no padding");

__global__ void __launch_bounds__(NWAVES * 64, 2) mk_fwd(Args args) {
    extern __shared__ __attribute__((aligned(16))) unsigned char lds_raw[];
    Frame F;
    F.lds = (LAS unsigned char*)lds_raw;
    F.tid = threadIdx.x; F.lane = F.tid & 63; F.wave = __builtin_amdgcn_readfirstlane(F.tid >> 6);
    F.G = gridDim.x; { const int bx = blockIdx.x; F.vcu = (F.G % 8 == 0) ? (bx % 8) * (F.G / 8) + bx / 8 : bx; }
    unsigned char* ws = args.ws;
    const float* x = args.in[0];
    const float* mix_pre_g = args.in[1]; const float* mix_post_g = args.in[2]; const float* ffn_pre_g = args.in[3]; const float* ffn_post_g = args.in[4];
    float* out = args.out;
    bf16* XN = (bf16*)(ws + WS_XN); bf16* G0 = (bf16*)(ws + WS_G0); bf16* C0 = (bf16*)(ws + WS_C0); bf16* HF = (bf16*)(ws + WS_HF);
    bf16* Qb = (bf16*)(ws + WS_Q); bf16* Kb = (bf16*)(ws + WS_K); bf16* Vb = (bf16*)(ws + WS_V); float* Y = (float*)(ws + WS_Y);
#if MK_COOP == 1
    cg::grid_group grid = cg::this_grid();
#elif MK_COOP == 2
    for (int u = F.tid; u < (LDS_BYTES - LDSCTL_OFF) / 4; u += NWAVES * 64) ((LAS unsigned*)(F.lds + LDSCTL_OFF))[u] = 0u;
    __syncthreads();
    XcdBarrier bar = xcd_barrier_post((unsigned*)(args.ws + WS_CTL) + CW_BAR, (volatile LAS unsigned*)(F.lds + MISC_OFF) + 8);
#endif
#ifndef PH_MASK
#define PH_MASK 0x7fff
#endif
#define PH_ON(k) ((PH_MASK >> (k)) & 1)
#ifndef REP_MASK
#define REP_MASK 0
#endif
    for (int ph2 = 2 * args.ph_lo; ph2 < 2 * args.ph_hi; ++ph2) {
        const int ph = ph2 >> 1;
        if ((ph2 & 1) && !((REP_MASK >> ph) & 1)) continue;
#if MK_COOP == 1
        if (ph2 != 2 * args.ph_lo) grid.sync();
#elif MK_COOP == 2
        if (ph2 != 2 * args.ph_lo) xcd_barrier(bar);
#endif
        { int t_ = threadIdx.x; asm volatile("" : "+v"(t_)); F.tid = t_; F.lane = t_ & 63; F.wave = __builtin_amdgcn_readfirstlane(t_ >> 6); }
        { long z_ = 0; asm volatile("" : "+s"(z_)); ws = args.ws + z_; out = args.out + z_; x = args.in[0] + z_; }
        XN = (bf16*)(ws + WS_XN); G0 = (bf16*)(ws + WS_G0); C0 = (bf16*)(ws + WS_C0); HF = (bf16*)(ws + WS_HF);
        Qb = (bf16*)(ws + WS_Q); Kb = (bf16*)(ws + WS_K); Vb = (bf16*)(ws + WS_V); Y = (float*)(ws + WS_Y);
        if (ph == 0 && PH_ON(0)) {
            LAS float* scr = (LAS float*)(F.lds + F.wave * 16384);
            const int gw = F.vcu * NWAVES + F.wave, NGW = F.G * NWAVES;
            int it0 = 0;
#define P0_JOB(Wp, WTp, Kd, Nd, halfd) do { const float* W_ = (Wp); bf16* WT_ = (bf16*)(WTp); const int K_ = (Kd), N_ = (Nd), half_ = (halfd); const int nblk = N_ / 32, nitems = (K_ / 64) * nblk; \
                const int first = ((gw - it0) % NGW + NGW) % NGW; \
                for (int it = first; it < nitems; it += NGW) { const int kb = it / nblk, nb = it % nblk, n0 = 32 * nb; const int drow = half_ ? gate_row(n0, half_) : n0; \
                    p0_transpose_item(W_, K_, N_, WT_, 64 * kb, n0, drow, scr, F.lane); } \
                it0 += nitems; } while (0)
            P0_JOB(args.in[5], ws + WS_WIN, D, 2 * D, D);
            P0_JOB(args.in[11], ws + WS_WOUT, D, D, 0);
            P0_JOB(args.in[13], ws + WS_WQKV, D, NQKV, 0);
            P0_JOB(args.in[15], ws + WS_WO, D, D, 0);
            P0_JOB(args.in[19], ws + WS_WGU0, D, 2 * DFF, DFF);
            P0_JOB(args.in[19] + (size_t)D * 2 * DFF, ws + WS_WGU1, D, 2 * DFF, DFF);
            P0_JOB(args.in[20], ws + WS_WD0, DFF, D, 0);
            P0_JOB(args.in[20] + (size_t)DFF * D, ws + WS_WD1, DFF, D, 0);
#undef P0_JOB
            f32x4 g[4];
#pragma unroll
            for (int j = 0; j < 4; ++j) g[j] = ((const f32x4*)mix_pre_g)[F.lane + 64 * j];
            for (int m = gw; m < M; m += NGW) rms_row_to_bf16(x + (size_t)m * D, XN + (size_t)m * D, g, F.lane);
        } else if ((ph == 1 || ph == 5 || ph == 12) && PH_ON(1)) {
            if (ph == 1) { pg8::Gemm gm{XN, (const bf16*)(ws + WS_WIN), M, 2 * D, D}; pg8::StaticOrder S; S.init(M, 2 * D, F.G, (int)blockIdx.x);
                pg8::EpiGate<0> E{G0, D, args.in[6], D, 0};
                pg8::gemm_phase<pg8::EpiGate<0>, pg8::StaticOrder, PG8_ALIGN, PG8_SP2>(F.lds, gm, S, E, F.tid);
            } else { pg8::Gemm gm{XN, (const bf16*)(ws + (ph == 5 ? WS_WGU0 : WS_WGU1)), M, 2 * DFF, D}; pg8::StaticOrder S; S.init(M, 2 * DFF, F.G, (int)blockIdx.x);
                pg8::EpiGate<1> E{HF, DFF, nullptr, DFF, 1};
                pg8::gemm_phase<pg8::EpiGate<1>, pg8::StaticOrder, PG8_ALIGN, PG8_SP2>(F.lds, gm, S, E, F.tid); }
        } else if (ph == 2 && PH_ON(2)) {
            conv_phase(F, G0, C0, args.in[7], args.in[8], args.in[9], args.in[10]);
        } else if ((ph == 3 || ph == 6 || ph == 10 || ph == 13) && PH_ON(3)) {
            pg8::Gemm gm; const float* bias;
            if (ph == 3) { gm = pg8::Gemm{C0, (const bf16*)(ws + WS_WOUT), M, D, D}; bias = args.in[12]; }
            else if (ph == 10) { gm = pg8::Gemm{Qb, (const bf16*)(ws + WS_WO), M, D, D}; bias = args.in[16]; }
            else { gm = pg8::Gemm{HF, (const bf16*)(ws + (ph == 6 ? WS_WD0 : WS_WD1)), M, D, DFF, 1, 0}; bias = nullptr; }
            pg8::StaticOrder S; S.init(M, D, F.G, (int)blockIdx.x);
            pg8::EpiF32 E{Y, D, bias};
            pg8::gemm_phase<pg8::EpiF32, pg8::StaticOrder, PG8_ALIGN, PG8_SP2>(F.lds, gm, S, E, F.tid);
        } else if (ph == 4 && PH_ON(4)) { thin_phase(F, Y, x, out, XN, mix_post_g, ffn_pre_g);
        } else if (ph == 7 && PH_ON(4)) { thin_phase(F, Y, out, out, XN, ffn_post_g, mix_pre_g + D);
        } else if (ph == 11 && PH_ON(4)) { thin_phase(F, Y, out, out, XN, mix_post_g + D, ffn_pre_g + D);
        } else if (ph == 14 && PH_ON(4)) { thin_phase(F, Y, out, out, XN, ffn_post_g + D, nullptr);
        } else if (ph == 8 && PH_ON(8)) {
            pg8::Gemm gm{XN, (const bf16*)(ws + WS_WQKV), M, NQKV, D}; pg8::StaticOrder S; S.init(M, NQKV, F.G, (int)blockIdx.x);
            pg8::EpiQKV E{Qb, Kb, Vb, args.in[14], QSCALE};
            pg8::gemm_phase<pg8::EpiQKV, pg8::StaticOrder, PG8_ALIGN, PG8_SP2>(F.lds, gm, S, E, F.tid);
        } else if (ph == 9 && PH_ON(9)) {
            attn_phase(F, Qb, Kb, Vb, Qb, args.in[17], args.in[18]);
        }
    }
}

extern "C" void kernel_launch(void* const* d_in, const int* in_sizes, int n_in, void* d_out, int out_size, void* d_ws, size_t ws_size, hipStream_t stream) {
    static int grid = 0;
    if (grid == 0) {
        if (n_in != 21 || in_sizes[0] != M * D || out_size != M * D || ws_size < WS_END) { fprintf(stderr, "kernel_launch: unexpected shapes (n_in %d, in0 %d, out %d, ws %zu)\n", n_in, n_in > 0 ? in_sizes[0] : -1, out_size, ws_size); grid = -1; return; }
        int dev = 0, cus = 0, per_cu = 0;
        if (hipGetDevice(&dev) != hipSuccess || hipDeviceGetAttribute(&cus, hipDeviceAttributeMultiprocessorCount, dev) != hipSuccess) { grid = -1; return; }
        if (hipFuncSetAttribute((const void*)mk_fwd, hipFuncAttributeMaxDynamicSharedMemorySize, LDS_BYTES) != hipSuccess) { fprintf(stderr, "kernel_launch: hipFuncSetAttribute failed\n"); grid = -1; return; }
        if (hipOccupancyMaxActiveBlocksPerMultiprocessor(&per_cu, (const void*)mk_fwd, NWAVES * 64, LDS_BYTES) != hipSuccess || per_cu < 1) { fprintf(stderr, "kernel_launch: occupancy query says %d\n", per_cu); per_cu = 1; }
        (void)hipGetLastError();
        grid = cus * 1;
    }
    if (grid < 0) return;
    Args a{};
    for (int i = 0; i < 21; ++i) a.in[i] = (const float*)d_in[i];
    a.out = (float*)d_out; a.ws = (unsigned char*)d_ws;
#if MK_COOP == 2
    if (hipMemsetAsync((char*)d_ws + WS_CTL, 0, CTL_ZERO_BYTES, stream) != hipSuccess) { fprintf(stderr, "kernel_launch: hipMemsetAsync failed\n"); return; }
    a.ph_lo = 0; a.ph_hi = NPHASE;
    hipLaunchKernelGGL(mk_fwd, dim3(grid), dim3(NWAVES * 64), LDS_BYTES, stream, a);
#elif MK_COOP == 1
    a.ph_lo = 0; a.ph_hi = NPHASE;
    void* kargs[] = {&a};
    hipError_t e = hipLaunchCooperativeKernel((const void*)mk_fwd, dim3(grid), dim3(NWAVES * 64), kargs, LDS_BYTES, stream);
    if (e != hipSuccess) fprintf(stderr, "kernel_launch: cooperative launch failed: %s (grid %d)\n", hipGetErrorString(e), grid);
#else
    for (int ph = 0; ph < NPHASE; ++ph) { a.ph_lo = ph; a.ph_hi = ph + 1; hipLaunchKernelGGL(mk_fwd, dim3(grid), dim3(NWAVES * 64), LDS_BYTES, stream, a); }
#endif
}
```

```cpp
#include <hip/hip_runtime.h>
#include <cstdio>
#include <cstdint>
__device__ __forceinline__ float sigmoid_f(float x) { return __builtin_amdgcn_rcpf(1.0f + __builtin_amdgcn_exp2f(-1.4426950408889634f * x)); }
namespace pg8 {
#define PG8_LAS __attribute__((address_space(3)))
typedef unsigned short bf16_t;
typedef short bf16x8 __attribute__((ext_vector_type(8)));
typedef float f32x4 __attribute__((ext_vector_type(4)));
typedef unsigned u32x4 __attribute__((ext_vector_type(4)));
constexpr int BM = 256, BK = 64, HALF = 128, HTB = HALF * BK * 2  , STAGE_BYTES = 8 * HTB, NXCD = 8, WGM = 8;

__host__ __device__ __forceinline__ int lds_byte(int r, int c) { const int st = (r >> 4) * 2 + (c >> 5), rr = r & 15, cc = c & 31, ob = rr * 64 + cc * 2; return st * 1024 + (ob ^ (((ob >> 9) & 1) << 5)); }
__host__ __device__ __forceinline__ void stage_rc(int b, int& R, int& C) { const int st = b / 1024, sb = b % 1024, swz = sb ^ (((sb >> 9) & 1) << 5); R = (st >> 1) * 16 + swz / 64; C = (st & 1) * 32 + (swz % 64) / 2; }
__host__ __device__ __forceinline__ int perm32(int rho) { const int n = rho >> 4, i = rho & 15; return 8 * (i >> 2) + 4 * n + (i & 3); }

struct Unit { int pm, pn; };
struct Gemm { const bf16_t* A; const bf16_t* Bt; int M, N, K; int a_tiled = 0, b_tiled = 0; };

struct StaticOrder {
    int nM, nN, nwg, G, c; int pmx = 0;
    __host__ __device__ void init(int M, int N, int G_, int c_) { nM = M / BM; nN = N / BM; nwg = nM * nN; G = G_; c = c_; }
    __host__ __device__ bool next(int i, Unit& u) const {
        const long L = (long)i * G + c; if (L >= nwg) return false;
        int wgid = (int)L; { const int q = nwg / NXCD, r = nwg % NXCD, xcd = wgid % NXCD, off = wgid / NXCD; wgid = (xcd < r ? xcd * (q + 1) : r * (q + 1) + (xcd - r) * q) + off; }
        const int nig = WGM * nN, gid = wgid / nig, fm = gid * WGM, gsz = (nM - fm) < WGM ? (nM - fm) : WGM;
        u.pm = (fm + ((wgid % nig) % gsz)) ^ pmx; u.pn = (wgid % nig) / gsz; return true;
    }
    __device__ __forceinline__ void a_ready(const Unit&) const {}
    __device__ __forceinline__ void done(const Unit&) const {}
};


__device__ __forceinline__ unsigned cvt_pk_bf16(float lo, float hi) { unsigned r; asm volatile("v_cvt_pk_bf16_f32 %0, %1, %2" : "=v"(r) : "v"(lo), "v"(hi)); return r; }

struct EpiF32 {
    static constexpr bool PERM = false, AFTER_DRAIN = false;
    float* C; int ldc; const float* bias;
    __device__ __forceinline__ void operator()(const f32x4 (&acc)[2][2][4][2], const Unit& u, int wr, int wc, int fr, int fq) const {
        const int row0 = u.pm * BM + wr * 64 + fr, col0 = u.pn * BM + wc * 32 + 4 * fq;
        f32x4 bv[2][2];
#pragma unroll
        for (int bj = 0; bj < 2; ++bj)
#pragma unroll
            for (int n = 0; n < 2; ++n) bv[bj][n] = bias ? *(const f32x4*)(bias + col0 + bj * HALF + n * 16) : (f32x4){0.f, 0.f, 0.f, 0.f};
#pragma unroll
        for (int ai = 0; ai < 2; ++ai)
#pragma unroll
            for (int m = 0; m < 4; ++m) { float* rowp = C + (size_t)(row0 + ai * HALF + m * 16) * ldc + col0;
#pragma unroll
                for (int bj = 0; bj < 2; ++bj)
#pragma unroll
                    for (int n = 0; n < 2; ++n) *(f32x4*)(rowp + bj * HALF + n * 16) = acc[ai][bj][m][n] + bv[bj][n]; }
    }
};
struct EpiBf16 {
    static constexpr bool PERM = true, AFTER_DRAIN = false;
    bf16_t* O; int ldc; const float* bias;
    __device__ __forceinline__ void operator()(const f32x4 (&acc)[2][2][4][2], const Unit& u, int wr, int wc, int fr, int fq) const {
        const int row0 = u.pm * BM + wr * 64 + fr, col0 = u.pn * BM + wc * 32 + 8 * fq;
        f32x4 bv[2][2];
#pragma unroll
        for (int bj = 0; bj < 2; ++bj)
#pragma unroll
            for (int n = 0; n < 2; ++n) bv[bj][n] = bias ? *(const f32x4*)(bias + col0 + bj * HALF + 4 * n) : (f32x4){0.f, 0.f, 0.f, 0.f};
#pragma unroll
        for (int ai = 0; ai < 2; ++ai)
#pragma unroll
            for (int m = 0; m < 4; ++m) { bf16_t* rowp = O + (size_t)(row0 + ai * HALF + m * 16) * ldc + col0;
#pragma unroll
                for (int bj = 0; bj < 2; ++bj) { const f32x4 v0 = acc[ai][bj][m][0] + bv[bj][0], v1 = acc[ai][bj][m][1] + bv[bj][1];
                    u32x4 w; w.x = cvt_pk_bf16(v0[0], v0[1]); w.y = cvt_pk_bf16(v0[2], v0[3]); w.z = cvt_pk_bf16(v1[0], v1[1]); w.w = cvt_pk_bf16(v1[2], v1[3]);
                    *(u32x4*)(rowp + bj * HALF) = w; } }
    }
};
template <int ACT> struct EpiGate {
    static constexpr bool PERM = true, AFTER_DRAIN = false;
    bf16_t* O; int ldc; const float* bias; int half_cols; int tiled;
    __device__ __forceinline__ void operator()(const f32x4 (&acc)[2][2][4][2], const Unit& u, int wr, int wc, int fr, int fq) const {
        const int row0 = u.pm * BM + wr * 64 + fr, oc0 = u.pn * HALF + wc * 32 + 8 * fq;
        const size_t tbase = tiled ? ((size_t)u.pm * (ldc >> 6) + (oc0 >> 6)) * (BM * BK) + (oc0 & 63) : 0;
        f32x4 bv[2][2];
#pragma unroll
        for (int bj = 0; bj < 2; ++bj)
#pragma unroll
            for (int n = 0; n < 2; ++n) bv[bj][n] = bias ? *(const f32x4*)(bias + bj * half_cols + oc0 + 4 * n) : (f32x4){0.f, 0.f, 0.f, 0.f};
#pragma unroll
        for (int ai = 0; ai < 2; ++ai)
#pragma unroll
            for (int m = 0; m < 4; ++m) { bf16_t* rowp = tiled ? O + tbase + (size_t)(wr * 64 + fr + ai * HALF + m * 16) * BK : O + (size_t)(row0 + ai * HALF + m * 16) * ldc + oc0;
                float r[8];
#pragma unroll
                for (int n = 0; n < 2; ++n) { const f32x4 a = acc[ai][0][m][n] + bv[0][n], b = acc[ai][1][m][n] + bv[1][n];
#pragma unroll
                    for (int j = 0; j < 4; ++j) r[4 * n + j] = (ACT == 0) ? a[j] * sigmoid_f(b[j]) : a[j] * sigmoid_f(a[j]) * b[j]; }
                u32x4 w; w.x = cvt_pk_bf16(r[0], r[1]); w.y = cvt_pk_bf16(r[2], r[3]); w.z = cvt_pk_bf16(r[4], r[5]); w.w = cvt_pk_bf16(r[6], r[7]);
                *(u32x4*)rowp = w; asm volatile("" ::: "memory"); }
    }
};
struct EpiQKV {
    static constexpr bool PERM = true, AFTER_DRAIN = false;
    bf16_t* Q; bf16_t* Kp; bf16_t* Vp; const float* bias; float qscale;
    __device__ __forceinline__ void operator()(const f32x4 (&acc)[2][2][4][2], const Unit& u, int wr, int wc, int fr, int fq) const {
        const int row0 = u.pm * BM + wr * 64 + fr; const int colt = u.pn * BM;
        bf16_t* base; int ldc, c0; float sc = 1.f;
        if (colt < 1024) { base = Q; ldc = 1024; c0 = colt; sc = qscale; } else if (colt < 1280) { base = Kp; ldc = 256; c0 = 0; } else { base = Vp; ldc = 256; c0 = 0; }
        const int col0 = c0 + wc * 32 + 8 * fq, bcol0 = colt + wc * 32 + 8 * fq;
        f32x4 bv[2][2];
#pragma unroll
        for (int bj = 0; bj < 2; ++bj)
#pragma unroll
            for (int n = 0; n < 2; ++n) bv[bj][n] = *(const f32x4*)(bias + bcol0 + bj * HALF + 4 * n);
#pragma unroll
        for (int ai = 0; ai < 2; ++ai)
#pragma unroll
            for (int m = 0; m < 4; ++m) { bf16_t* rowp = base + (size_t)(row0 + ai * HALF + m * 16) * ldc + col0;
#pragma unroll
                for (int bj = 0; bj < 2; ++bj) { const f32x4 v0 = (acc[ai][bj][m][0] + bv[bj][0]) * sc, v1 = (acc[ai][bj][m][1] + bv[bj][1]) * sc;
                    u32x4 w; w.x = cvt_pk_bf16(v0[0], v0[1]); w.y = cvt_pk_bf16(v0[2], v0[3]); w.z = cvt_pk_bf16(v1[0], v1[1]); w.w = cvt_pk_bf16(v1[2], v1[3]);
                    *(u32x4*)(rowp + bj * HALF) = w; } }
    }
};

template <class Epi, class Sched, bool ALIGN_EPI = false, bool SP2 = false>
__device__ __forceinline__ void gemm_phase(PG8_LAS unsigned char* lds, const Gemm g, const Sched& S, const Epi& E, const int tid) {
    const int wid = __builtin_amdgcn_readfirstlane(tid >> 6), lane = tid & 63, wr = wid >> 2, wc = wid & 3, fr = lane & 15, fq = lane >> 4;
    const int K = g.K, nt = K / BK;
    unsigned voffA[2], voffB[2];
#pragma unroll
    for (int i = 0; i < 2; ++i) { int R, C; stage_rc(tid * 16 + i * 8192, R, C); const int Rb = Epi::PERM ? ((R & ~31) + perm32(R & 31)) : R;
        voffA[i] = (unsigned)(R * (g.a_tiled ? BK : K) + C) * 2u; voffB[i] = (unsigned)(Rb * (g.b_tiled ? BK : K) + C) * 2u; }
    const size_t kstepA = g.a_tiled ? (size_t)(BM * BK * 2) : (size_t)(BK * 2), kstepB = g.b_tiled ? (size_t)(BM * BK * 2) : (size_t)(BK * 2);
    const size_t hstepA = g.a_tiled ? (size_t)(HALF * BK * 2) : (size_t)HALF * K * 2, hstepB = g.b_tiled ? (size_t)(HALF * BK * 2) : (size_t)HALF * K * 2;
    const size_t tstep = (size_t)BM * K * 2;
    const unsigned ldsw = (unsigned)wid * 1024u;
    const int aoff = lds_byte(wr * 64 + fr, fq * 8), boff = lds_byte(wc * 32 + fr, fq * 8);
#define PG8_SA(b, h) (((b) * 2 + (h)) * HTB)
#define PG8_SB(b, h) ((4 + (b) * 2 + (h)) * HTB)
#define PG8_STAGE(bufoff, gbase, voff) do { _Pragma("unroll") for (int _i = 0; _i < 2; ++_i) \
        __builtin_amdgcn_global_load_lds((const unsigned*)((const char*)(gbase) + (voff)[_i]), (PG8_LAS unsigned*)(lds + (bufoff) + ldsw + _i * 8192), 16, 0, 0); } while (0)
#define PG8_LDA(dst, b, h) do { _Pragma("unroll") for (int m = 0; m < 4; ++m) _Pragma("unroll") for (int k = 0; k < 2; ++k) dst[m][k] = *(const PG8_LAS bf16x8*)(lds + PG8_SA(b, h) + aoff + m * 2048 + k * 1024); } while (0)
#define PG8_LDB(dst, b, h) do { _Pragma("unroll") for (int n = 0; n < 2; ++n) _Pragma("unroll") for (int k = 0; k < 2; ++k) dst[n][k] = *(const PG8_LAS bf16x8*)(lds + PG8_SB(b, h) + boff + n * 2048 + k * 1024); } while (0)
#define PG8_MMA(ai, bj, At, Bt) do { __builtin_amdgcn_s_setprio(1); _Pragma("unroll") for (int m = 0; m < 4; ++m) _Pragma("unroll") for (int n = 0; n < 2; ++n) _Pragma("unroll") for (int k = 0; k < 2; ++k) \
        acc[ai][bj][m][n] = __builtin_amdgcn_mfma_f32_16x16x32_bf16(Bt[n][k], At[m][k], acc[ai][bj][m][n], 0, 0, 0); __builtin_amdgcn_s_setprio(0); } while (0)
#define PG8_WAIT_V(n) asm volatile("s_waitcnt vmcnt(" #n ")" ::: "memory")
#define PG8_WAIT_L(n) asm volatile("s_waitcnt lgkmcnt(" #n ")" ::: "memory")
#define PG8_BAR __builtin_amdgcn_s_barrier()
#define PG8_SCHED __builtin_amdgcn_sched_barrier(0)
    Unit cur, nxt; int ui = 0;
    if (!S.next(0, cur)) return;
    f32x4 acc[2][2][4][2];
#pragma unroll
    for (int a = 0; a < 2; ++a)
#pragma unroll
        for (int b = 0; b < 2; ++b)
#pragma unroll
            for (int m = 0; m < 4; ++m)
#pragma unroll
                for (int n = 0; n < 2; ++n) acc[a][b][m][n] = (f32x4){0.f, 0.f, 0.f, 0.f};
    bf16x8 At[4][2], B0[2][2], B1[2][2];
    const char* cA = (const char*)g.A + (size_t)cur.pm * tstep; const char* cB = (const char*)g.Bt + (size_t)cur.pn * tstep;
    S.a_ready(cur);
    if constexpr (SP2) {
        PG8_STAGE(PG8_SB(0, 0), cB, voffB); PG8_STAGE(PG8_SB(0, 1), cB + hstepB, voffB); PG8_STAGE(PG8_SA(0, 0), cA, voffA); PG8_STAGE(PG8_SA(0, 1), cA + hstepA, voffA);
        if (wr == 1) PG8_BAR;
        PG8_WAIT_V(2); PG8_BAR;
        PG8_STAGE(PG8_SB(1, 0), cB + kstepB, voffB); PG8_STAGE(PG8_SA(1, 0), cA + kstepA, voffA); PG8_STAGE(PG8_SB(1, 1), cB + hstepB + kstepB, voffB);
        PG8_WAIT_V(6); PG8_BAR;
    } else {
        PG8_STAGE(PG8_SB(0, 0), cB, voffB); PG8_STAGE(PG8_SA(0, 0), cA, voffA); PG8_STAGE(PG8_SB(0, 1), cB + hstepB, voffB); PG8_STAGE(PG8_SA(0, 1), cA + hstepA, voffA);
        if (wr == 1) PG8_BAR;
        PG8_WAIT_V(4); PG8_BAR;
        PG8_STAGE(PG8_SB(1, 0), cB + kstepB, voffB); PG8_STAGE(PG8_SA(1, 0), cA + kstepA, voffA); PG8_STAGE(PG8_SB(1, 1), cB + hstepB + kstepB, voffB);
        PG8_WAIT_V(6); PG8_BAR;
    }
    for (;;) {
        const bool has_next = S.next(ui + 1, nxt);
        const char* nA = has_next ? (const char*)g.A + (size_t)nxt.pm * tstep : cA; const char* nB = has_next ? (const char*)g.Bt + (size_t)nxt.pn * tstep : cB;
        for (int t = 0; t < nt; t += 2) {
            const bool last = (t == nt - 2);
            const char* a1 = cA + (size_t)(t + 1) * kstepA;
            const char* a2 = last ? nA : cA + (size_t)(t + 2) * kstepA; const char* b2 = last ? nB : cB + (size_t)(t + 2) * kstepB;
            const char* a3 = a2 + kstepA; const char* b3 = b2 + kstepB;
            if (last && has_next) S.a_ready(nxt);
            if constexpr (SP2) {
            PG8_LDB(B0, 0, 0); PG8_LDB(B1, 0, 1); PG8_SCHED; PG8_LDA(At, 0, 0); PG8_STAGE(PG8_SA(1, 1), a1 + hstepA, voffA);
            PG8_WAIT_V(8); PG8_WAIT_L(0); PG8_BAR; PG8_MMA(0, 0, At, B0); PG8_MMA(0, 1, At, B1); PG8_BAR; PG8_SCHED;
            PG8_LDA(At, 0, 1); PG8_STAGE(PG8_SB(0, 0), b2, voffB); PG8_STAGE(PG8_SB(0, 1), b2 + hstepB, voffB); PG8_STAGE(PG8_SA(0, 0), a2, voffA);
            PG8_WAIT_V(8); PG8_WAIT_L(0); PG8_BAR; PG8_MMA(1, 0, At, B0); PG8_MMA(1, 1, At, B1); PG8_BAR; PG8_SCHED;
            PG8_LDB(B0, 1, 0); PG8_LDB(B1, 1, 1); PG8_SCHED; PG8_LDA(At, 1, 0); PG8_STAGE(PG8_SA(0, 1), a2 + hstepA, voffA);
            PG8_WAIT_V(8); PG8_WAIT_L(0); PG8_BAR; PG8_MMA(0, 0, At, B0); PG8_MMA(0, 1, At, B1); PG8_BAR; PG8_SCHED;
            PG8_LDA(At, 1, 1); PG8_STAGE(PG8_SB(1, 0), b3, voffB); PG8_STAGE(PG8_SB(1, 1), b3 + hstepB, voffB); PG8_STAGE(PG8_SA(1, 0), a3, voffA);
            PG8_WAIT_V(8); PG8_WAIT_L(0); PG8_BAR; PG8_MMA(1, 0, At, B0); PG8_MMA(1, 1, At, B1); PG8_BAR; PG8_SCHED;
            } else {
            PG8_LDB(B0, 0, 0); PG8_SCHED; PG8_LDA(At, 0, 0); PG8_STAGE(PG8_SA(1, 1), a1 + hstepA, voffA);
            PG8_WAIT_L(8); PG8_BAR; PG8_WAIT_L(0); PG8_MMA(0, 0, At, B0); PG8_BAR; PG8_SCHED;
            PG8_LDB(B1, 0, 1); PG8_STAGE(PG8_SB(0, 0), b2, voffB);
            PG8_BAR; PG8_WAIT_L(0); PG8_MMA(0, 1, At, B1); PG8_BAR;
            PG8_LDA(At, 0, 1); PG8_STAGE(PG8_SA(0, 0), a2, voffA);
            PG8_BAR; PG8_WAIT_L(0); PG8_MMA(1, 0, At, B0); PG8_BAR; PG8_SCHED;
            PG8_STAGE(PG8_SB(0, 1), b2 + hstepB, voffB);
            PG8_WAIT_V(6); PG8_BAR; PG8_MMA(1, 1, At, B1); PG8_BAR;
            PG8_LDB(B0, 1, 0); PG8_SCHED; PG8_LDA(At, 1, 0); PG8_STAGE(PG8_SA(0, 1), a2 + hstepA, voffA);
            PG8_WAIT_L(8); PG8_BAR; PG8_WAIT_L(0); PG8_MMA(0, 0, At, B0); PG8_BAR; PG8_SCHED;
            PG8_LDB(B1, 1, 1); PG8_STAGE(PG8_SB(1, 0), b3, voffB);
            PG8_BAR; PG8_WAIT_L(0); PG8_MMA(0, 1, At, B1); PG8_BAR;
            PG8_LDA(At, 1, 1); PG8_STAGE(PG8_SA(1, 0), a3, voffA);
            PG8_BAR; PG8_WAIT_L(0); PG8_MMA(1, 0, At, B0); PG8_BAR; PG8_SCHED;
            PG8_STAGE(PG8_SB(1, 1), b3 + hstepB, voffB);
            PG8_WAIT_V(6); PG8_BAR; PG8_MMA(1, 1, At, B1); PG8_BAR;
            }
        }
        if constexpr (ALIGN_EPI) { if (wr == 0) PG8_BAR; }
        if constexpr (!Epi::AFTER_DRAIN) { E(acc, cur, wr, wc, fr, fq); S.done(cur); }
        if (!has_next) break;
#pragma unroll
        for (int a = 0; a < 2; ++a)
#pragma unroll
            for (int b = 0; b < 2; ++b)
#pragma unroll
                for (int m = 0; m < 4; ++m)
#pragma unroll
                    for (int n = 0; n < 2; ++n) acc[a][b][m][n] = (f32x4){0.f, 0.f, 0.f, 0.f};
        cur = nxt; cA = nA; cB = nB; ++ui;
        if constexpr (ALIGN_EPI) { if (wr == 1) PG8_BAR; }
    }
    PG8_WAIT_V(0);
    if constexpr (!ALIGN_EPI) { if (wr == 0) PG8_BAR; }
    PG8_BAR;
    if constexpr (Epi::AFTER_DRAIN) { E.fused(acc, cur, wr, wc, fr, fq, lds, wid, lane); S.done(cur); }
#undef PG8_SA
#undef PG8_SB
#undef PG8_STAGE
#undef PG8_LDA
#undef PG8_LDB
#undef PG8_MMA
#undef PG8_WAIT_V
#undef PG8_WAIT_L
#undef PG8_BAR
#undef PG8_SCHED
}
}

#ifndef PG8_SP2
#define PG8_SP2 true
#endif
#ifndef PG8_ALIGN
#define PG8_ALIGN true
#endif
#ifndef MK_COOP
#define MK_COOP 2
#endif
#if MK_COOP == 1
#include <hip/hip_cooperative_groups.h>
namespace cg = cooperative_groups;
#endif

constexpr int BATCH = 4, SEQ = 8192, D = 1024, M = BATCH * SEQ, DFF = 2816, NQKV = 1536, NH = 16, NKV = 4, HD = 64, CW = 31;
constexpr float EPS = 1e-6f;
constexpr float LOG2E = 1.4426950408889634f;
constexpr float QSCALE = 0.125f * LOG2E;
constexpr int NWAVES = 8;
constexpr int NPHASE = 15;

constexpr size_t MiB = 1u << 20;
constexpr size_t WS_WIN = 2 * MiB, WS_WOUT = 6 * MiB, WS_WQKV = 8 * MiB, WS_WO = 11 * MiB, WS_WGU0 = 13 * MiB, WS_WGU1 = 24 * MiB, WS_WD0 = 35 * MiB, WS_WD1 = 35 * MiB + 5632 * 1024, WS_WEND = 46 * MiB;
constexpr size_t WS_XN = 48 * MiB;
constexpr size_t WS_G0 = 112 * MiB, WS_C0 = 176 * MiB;
constexpr size_t WS_Q = 112 * MiB, WS_K = 176 * MiB, WS_V = 192 * MiB;
constexpr size_t WS_HF = 112 * MiB;
constexpr size_t WS_Y = 288 * MiB;
constexpr size_t WS_HB = 352 * MiB;
constexpr size_t WS_END = 416 * MiB;
static_assert(WS_WD1 + (size_t)D * DFF * 2 <= WS_WEND && WS_HF + (size_t)M * DFF * 2 <= WS_Y && WS_Y + (size_t)M * D * 2 <= WS_HB && WS_HB + (size_t)M * D * 2 <= WS_END, "d_ws map");

constexpr int LDS_BYTES = 147456;
constexpr int LDSCTL_OFF = 131072, MISC_OFF = LDSCTL_OFF + 320;
constexpr size_t WS_CTL = 0, CTL_ZERO_BYTES = 64 * 1024;
constexpr int CW_BAR = 4096;

#define GAS __attribute__((address_space(1)))
#define LAS __attribute__((address_space(3)))
typedef unsigned short bf16;
typedef unsigned v4u __attribute__((ext_vector_type(4)));
typedef unsigned v2u __attribute__((ext_vector_type(2)));
typedef float f32x4 __attribute__((ext_vector_type(4)));
typedef float f32x16 __attribute__((ext_vector_type(16)));
typedef short bf16x8 __attribute__((ext_vector_type(8)));
typedef short s16x4 __attribute__((ext_vector_type(4)));
#define LDS_WAIT() asm volatile("s_waitcnt lgkmcnt(0)" ::: "memory")

__device__ __forceinline__ unsigned pk2(float lo, float hi) { unsigned r; asm volatile("v_cvt_pk_bf16_f32 %0, %1, %2" : "=v"(r) : "v"(lo), "v"(hi)); return r; }
__device__ __forceinline__ float bf2f(unsigned short b) { return __builtin_bit_cast(float, (unsigned)b << 16); }
__device__ __forceinline__ float wave_sum(float v) {
#pragma unroll
    for (int o = 1; o < 64; o <<= 1) v += __shfl_xor(v, o);
    return v;
}

typedef GAS unsigned gu32;
#define RLX_AGENT __ATOMIC_RELAXED, __HIP_MEMORY_SCOPE_AGENT
#define XB_TMO      128
#define XB_XCNT(j)  (256  + 64 * (j))
#define XB_XSUB(j)  (1280 + 64 * (j))
#define XB_XGEN(j)  (2304 + 64 * (j))
#define XB_TOP      3328
#define XB_TOPGEN   3392
#define XCD_BAR_WORDS 3456
#define XB_SPIN_CAP (1u << 18)

__device__ __forceinline__ unsigned xb_ld(unsigned* p)              { return __hip_atomic_load(p, __ATOMIC_RELAXED, __HIP_MEMORY_SCOPE_AGENT); }
__device__ __forceinline__ unsigned xb_add(unsigned* p, unsigned v) { return __hip_atomic_fetch_add(p, v, __ATOMIC_RELAXED, __HIP_MEMORY_SCOPE_AGENT); }
__device__ __forceinline__ unsigned xb_xcc_id() { return (unsigned)__builtin_amdgcn_s_getreg((3 << 11) | 20) & 0xFu; }
#define XB_SPIN(cond, bar) do { unsigned _sp = 0; while (cond) { __builtin_amdgcn_s_sleep(1); \
    if ((++_sp & 255u) == 0u) { if (xb_ld(&(bar)[XB_TMO])) break; if (_sp > XB_SPIN_CAP) { atomicAdd(&(bar)[XB_TMO], 1u); break; } } } } while (0)

struct XcdBarrier {
    unsigned* bar; unsigned x;
    volatile LAS unsigned* st;
};

__device__ __forceinline__ XcdBarrier xcd_barrier_post(unsigned* bar, volatile LAS unsigned* st) {
    XcdBarrier b; b.bar = bar; b.x = xb_xcc_id(); b.st = st;
    if (threadIdx.x == 0) (void)xb_add(&bar[XB_XCNT(b.x)], 1u);
    return b;
}
__device__ __forceinline__ void xcd_barrier_complete(unsigned* bar, unsigned x, unsigned& nloc, unsigned& nx) {
    const unsigned G = gridDim.x * gridDim.y * gridDim.z;
    unsigned sum, cnt, mine, sp = 0u;
    for (;;) {
        sum = 0u; cnt = 0u; mine = 0u;
#pragma unroll
        for (unsigned j = 0; j < 16; ++j) { const unsigned c = xb_ld(&bar[XB_XCNT(j)]); sum += c; cnt += (c > 0u) ? 1u : 0u; mine = (j == x) ? c : mine; }
        if (sum == G) break;
        __builtin_amdgcn_s_sleep(1);
        if ((++sp & 255u) == 0u) { if (xb_ld(&bar[XB_TMO])) break; if (sp > XB_SPIN_CAP) { atomicAdd(&bar[XB_TMO], 1u); break; } }
    }
    nloc = mine > 0u ? mine : 1u; nx = cnt > 0u ? cnt : 1u;
}

__device__ __forceinline__ void xcd_barrier(const XcdBarrier& b) {
    asm volatile("s_waitcnt vmcnt(0)" ::: "memory");
    __syncthreads();
    if (threadIdx.x == 0) {
        unsigned* bar = b.bar;
        __builtin_amdgcn_s_waitcnt(0);
        unsigned nloc = b.st[0], nx = b.st[1];
        if (nloc == 0u) { xcd_barrier_complete(bar, b.x, nloc, nx); b.st[0] = nloc; b.st[1] = nx; }
        const unsigned old = xb_add(&bar[XB_XSUB(b.x)], 1u);
        const unsigned gen = old / nloc;
        if (old + 1u == (gen + 1u) * nloc) {
            __builtin_amdgcn_fence(__ATOMIC_RELEASE, "agent");
            asm volatile("s_waitcnt vmcnt(0)" ::: "memory");
            const unsigned og = xb_add(&bar[XB_TOP], 1u);
            const unsigned tg = og / nx;
            if (og + 1u == (tg + 1u) * nx) xb_add(&bar[XB_TOPGEN], 1u);
            else XB_SPIN(xb_ld(&bar[XB_TOPGEN]) == tg, bar);
            __builtin_amdgcn_fence(__ATOMIC_ACQUIRE, "agent");
            xb_add(&bar[XB_XGEN(b.x)], 1u);
            asm volatile("s_waitcnt vmcnt(0)" ::: "memory");
        } else {
            XB_SPIN(xb_ld(&bar[XB_XGEN(b.x)]) == gen, bar);
            __builtin_amdgcn_fence(__ATOMIC_ACQUIRE, "agent");
            asm volatile("s_waitcnt vmcnt(0)" ::: "memory");
        }
    }
    __syncthreads();
}

struct Frame {
    LAS unsigned char* lds;
    int tid, lane, wave, vcu, G;
};

__device__ __forceinline__ void p0_transpose_item(const float* W, int K, int N, bf16* WT, int k0, int n0, int drow, LAS float* scr, int lane) {
#pragma unroll 8
    for (int i = 0; i < 32; ++i) { const int kk = 2 * i + (lane >> 5); scr[kk * 33 + (lane & 31)] = W[(size_t)(k0 + kk) * N + n0 + (lane & 31)]; }
    LDS_WAIT(); asm volatile("" ::: "memory");
    const int c = lane & 7;
#pragma unroll
    for (int j = 0; j < 4; ++j) { const int n = (lane >> 3) + 8 * j; const LAS float* s = scr + (8 * c) * 33 + n;
        v4u o; o.x = pk2(s[0 * 33], s[1 * 33]); o.y = pk2(s[2 * 33], s[3 * 33]); o.z = pk2(s[4 * 33], s[5 * 33]); o.w = pk2(s[6 * 33], s[7 * 33]);
        *(v4u*)(WT + (size_t)(drow + n) * K + k0 + 8 * c) = o; }
    LDS_WAIT(); asm volatile("" ::: "memory");
}
__device__ __forceinline__ int gate_row(int n0, int half) { const int hsel = n0 >= half ? 1 : 0; const int c = n0 - hsel * half; return 256 * (c >> 7) + 128 * hsel + (c & 127); }


__device__ __forceinline__ void rms_row_to_bf16(const float* xrow, bf16* orow, const f32x4 (&g)[4], int lane) {
    const f32x4* xr = (const f32x4*)xrow + lane;
    f32x4 v[4]; float s = 0.f;
#pragma unroll
    for (int j = 0; j < 4; ++j) { v[j] = xr[64 * j]; s += (v[j].x * v[j].x + v[j].y * v[j].y) + (v[j].z * v[j].z + v[j].w * v[j].w); }
    const float rstd = rsqrtf(wave_sum(s) * (1.f / D) + EPS);
    v2u* o8 = (v2u*)orow + lane;
#pragma unroll
    for (int j = 0; j < 4; ++j) { v2u w; w.x = pk2(v[j].x * rstd * g[j].x, v[j].y * rstd * g[j].y); w.y = pk2(v[j].z * rstd * g[j].z, v[j].w * rstd * g[j].w); o8[64 * j] = w; }
}

__device__ __forceinline__ f32x4 bf4_to_f32(v2u w) { return (f32x4){__builtin_bit_cast(float, w.x << 16), __builtin_bit_cast(float, w.x & 0xffff0000u), __builtin_bit_cast(float, w.y << 16), __builtin_bit_cast(float, w.y & 0xffff0000u)}; }
template <bool BASE_BF16, bool OUT_BF16>
__device__ __forceinline__ void thin_phase(const Frame& F, const bf16* Y, const void* base, void* out, bf16* XN, const float* gpost, const float* gpre) {
    const int gw = F.vcu * NWAVES + F.wave, NGW = F.G * NWAVES, lane = F.lane;
    f32x4 gp[4], gq[4];
#pragma unroll
    for (int j = 0; j < 4; ++j) { gp[j] = ((const f32x4*)gpost)[lane + 64 * j]; gq[j] = gpre ? ((const f32x4*)gpre)[lane + 64 * j] : (f32x4){0.f, 0.f, 0.f, 0.f}; }
    for (int m = gw; m < M; m += NGW) {
        const v2u* yr = (const v2u*)(Y + (size_t)m * D) + lane;
        f32x4 y[4], h[4]; float s = 0.f;
#pragma unroll
        for (int j = 0; j < 4; ++j) { y[j] = bf4_to_f32(yr[64 * j]);
            if (BASE_BF16) h[j] = bf4_to_f32(((const v2u*)((const bf16*)base + (size_t)m * D) + lane)[64 * j]); else h[j] = ((const f32x4*)((const float*)base + (size_t)m * D) + lane)[64 * j]; }
#pragma unroll
        for (int j = 0; j < 4; ++j) s += (y[j].x * y[j].x + y[j].y * y[j].y) + (y[j].z * y[j].z + y[j].w * y[j].w);
        const float rstd = rsqrtf(wave_sum(s) * (1.f / D) + EPS);
        float s2 = 0.f;
#pragma unroll
        for (int j = 0; j < 4; ++j) { h[j] = h[j] + y[j] * rstd * gp[j];
            if (OUT_BF16) { v2u w; w.x = pk2(h[j].x, h[j].y); w.y = pk2(h[j].z, h[j].w); ((v2u*)((bf16*)out + (size_t)m * D) + lane)[64 * j] = w; h[j] = bf4_to_f32(w); }
            else ((f32x4*)((float*)out + (size_t)m * D) + lane)[64 * j] = h[j];
            s2 += (h[j].x * h[j].x + h[j].y * h[j].y) + (h[j].z * h[j].z + h[j].w * h[j].w); }
        if (gpre) {
            const float r2 = rsqrtf(wave_sum(s2) * (1.f / D) + EPS);
            v2u* o8 = (v2u*)(XN + (size_t)m * D) + lane;
#pragma unroll
            for (int j = 0; j < 4; ++j) { v2u w; w.x = pk2(h[j].x * r2 * gq[j].x, h[j].y * r2 * gq[j].y); w.y = pk2(h[j].z * r2 * gq[j].z, h[j].w * r2 * gq[j].w); o8[64 * j] = w; }
        }
    }
}

constexpr int CV_SEG = 128;
constexpr int CV_TILE = 0;
constexpr int CV_LNG = 65536, CV_LNB = 65536 + 4096;
template <int C4>
__device__ __forceinline__ void conv_chunk(float (&win0)[32], float (&win1)[32], const float (&w0)[CW], const float (&w1)[CW], unsigned (&buf)[8], const GAS bf16*& gp, bool more, float bias0, float bias1,
                                           LAS unsigned char* lds, bf16* orow, int tid, int wave, int lane) {
    typedef float f32x2 __attribute__((ext_vector_type(2)));
    LAS f32x2* tile = (LAS f32x2*)(lds + CV_TILE + (C4 & 1) * 32768);
#pragma unroll
    for (int kk = 0; kk < 8; ++kk) {
        const int k = C4 * 8 + kk;
        win0[k] = __builtin_bit_cast(float, buf[kk] << 16); win1[k] = __builtin_bit_cast(float, buf[kk] & 0xffff0000u);
        if (more) { asm volatile("" : "+v"(gp)); buf[kk] = *(const GAS unsigned*)gp; gp += D; }
        float a0 = bias0, a1 = bias1;
#pragma unroll
        for (int j = 0; j < CW; ++j) { a0 = __builtin_fmaf(w0[j], win0[(2 + k + j) & 31], a0); a1 = __builtin_fmaf(w1[j], win1[(2 + k + j) & 31], a1); }
        tile[kk * 512 + tid] = (f32x2){a0, a1};
    }
    __syncthreads();
    {
        const LAS f32x4* tr = (const LAS f32x4*)(lds + CV_TILE + (C4 & 1) * 32768 + wave * 4096) + lane;
        const LAS f32x4* lg = (const LAS f32x4*)(lds + CV_LNG) + lane; const LAS f32x4* lb = (const LAS f32x4*)(lds + CV_LNB) + lane;
        f32x4 v[4]; float sm = 0.f, q = 0.f;
#pragma unroll
        for (int j = 0; j < 4; ++j) { v[j] = tr[64 * j]; sm += (v[j].x + v[j].y) + (v[j].z + v[j].w); q += (v[j].x * v[j].x + v[j].y * v[j].y) + (v[j].z * v[j].z + v[j].w * v[j].w); }
        sm = wave_sum(sm); q = wave_sum(q);
        const float mean = sm * (1.f / D); const float rstd = rsqrtf(fmaxf(q * (1.f / D) - mean * mean, 0.f) + EPS);
        v2u* o8 = (v2u*)(orow + (size_t)wave * D) + lane;
#pragma unroll
        for (int j = 0; j < 4; ++j) { const f32x4 g = lg[64 * j], bb = lb[64 * j]; f32x4 y = (v[j] - mean) * rstd * g + bb;
            y.x = y.x * sigmoid_f(y.x); y.y = y.y * sigmoid_f(y.y); y.z = y.z * sigmoid_f(y.z); y.w = y.w * sigmoid_f(y.w);
            v2u w; w.x = pk2(y.x, y.y); w.y = pk2(y.z, y.w); o8[64 * j] = w; }
    }
}

__device__ __forceinline__ void conv_phase(const Frame& F, const bf16* G0, bf16* C0, const float* dww, const float* dwb, const float* lng, const float* lnb) {
    const int tid = F.tid, c = 2 * tid;
    for (int i = tid; i < D; i += NWAVES * 64) { ((LAS float*)(F.lds + CV_LNG))[i] = lng[i]; ((LAS float*)(F.lds + CV_LNB))[i] = lnb[i]; }
    float w0[CW], w1[CW];
    { const GAS float* wp = (const GAS float*)(dww + c);
#pragma unroll
      for (int j = 0; j < CW; ++j) { asm volatile("" : "+v"(wp)); typedef float f32x2g __attribute__((ext_vector_type(2))); const f32x2g w = *(const GAS f32x2g*)wp; w0[j] = w.x; w1[j] = w.y; wp += D; } }
    const float2 bb = *(const float2*)(dwb + c);
    __syncthreads();
    for (int seg = F.vcu; seg < M / CV_SEG; seg += F.G) {
        const int t0 = seg * CV_SEG; const bool first = (t0 % SEQ) == 0;
        float win0[32], win1[32];
        win0[0] = win0[1] = win1[0] = win1[1] = 0.f;
        const GAS bf16* gp = (const GAS bf16*)(G0 + ((long)t0 - 30) * D + c);
#pragma unroll
        for (int s = 2; s < 32; ++s) { unsigned v = 0u; if (!first) { asm volatile("" : "+v"(gp)); v = *(const GAS unsigned*)gp; } gp += D;
            win0[s] = __builtin_bit_cast(float, v << 16); win1[s] = __builtin_bit_cast(float, v & 0xffff0000u); }
        unsigned buf[8];
#pragma unroll
        for (int kk = 0; kk < 8; ++kk) { asm volatile("" : "+v"(gp)); buf[kk] = *(const GAS unsigned*)gp; gp += D; }
        for (int blk = 0; blk < CV_SEG / 32; ++blk) {
            const int r0 = t0 + blk * 32; const bool notlast = blk + 1 < CV_SEG / 32;
            conv_chunk<0>(win0, win1, w0, w1, buf, gp, true, bb.x, bb.y, F.lds, C0 + (size_t)r0 * D, tid, F.wave, F.lane);
            conv_chunk<1>(win0, win1, w0, w1, buf, gp, true, bb.x, bb.y, F.lds, C0 + (size_t)(r0 + 8) * D, tid, F.wave, F.lane);
            conv_chunk<2>(win0, win1, w0, w1, buf, gp, true, bb.x, bb.y, F.lds, C0 + (size_t)(r0 + 16) * D, tid, F.wave, F.lane);
            conv_chunk<3>(win0, win1, w0, w1, buf, gp, notlast, bb.x, bb.y, F.lds, C0 + (size_t)(r0 + 24) * D, tid, F.wave, F.lane);
        }
    }
    __syncthreads();
}

constexpr int AT_KS = 0;
constexpr int AT_VT = 32768;
constexpr int AT_VLD = 260;
constexpr int AT_BIAS = AT_VT + 64 * AT_VLD * 2 + 512;
constexpr int AT_SINK = AT_BIAS + 16 * 128 * 4;
static_assert(AT_BIAS % 16 == 0 && AT_SINK + 64 <= 131072, "attention LDS map");
__device__ __forceinline__ int t5_bucket(int d) {
    if (d < 16) return d;
    int b = 16;
    b += (d >= 19) + (d >= 21) + (d >= 24) + (d >= 27) + (d >= 31) + (d >= 35) + (d >= 40) + (d >= 46) + (d >= 52) + (d >= 59) + (d >= 67) + (d >= 77) + (d >= 87) + (d >= 99) + (d >= 113);
    return b;
}
__device__ __forceinline__ void attn_phase(const Frame& F, const bf16* Q, const bf16* Kg, const bf16* Vg, bf16* O, const float* sinks, const float* rel_bias) {
    LAS unsigned char* lds = F.lds;
    LAS float* bias2 = (LAS float*)(lds + AT_BIAS); LAS float* sink2 = (LAS float*)(lds + AT_SINK);
    const int tid = F.tid, lane = F.lane, wave = F.wave, r32 = lane & 31, hi = lane >> 5;
    for (int idx = tid; idx < 16 * 128; idx += NWAVES * 64) { const int h = idx >> 7, d = idx & 127; bias2[idx] = rel_bias[t5_bucket(d) * NH + h] * LOG2E; }
    if (tid < 16) sink2[tid] = sinks[tid] * LOG2E;
    __syncthreads();
    constexpr int NUNIT = BATCH * NKV * (SEQ / 128);
    const int upw = (NUNIT + F.G - 1) / F.G;
    for (int ui = 0; ui < upw; ++ui) {
        const int unit = F.vcu * upw + ui; if (unit >= NUNIT) break;
        const int n = unit & 63, kv = (unit >> 6) & 3, b = unit >> 8;
        const long rowbase = (long)b * SEQ + n * 128 - 128;
#pragma unroll
        for (int i = 0; i < 4; ++i) { const int q = tid + 512 * i, row = q >> 3, ch = q & 7; const bool ok = (n > 0) || (row >= 128);
            v4u kq = (v4u){0u, 0u, 0u, 0u}, vq = (v4u){0u, 0u, 0u, 0u};
            if (ok) { kq = *(const v4u*)(Kg + (size_t)(rowbase + row) * 256 + kv * 64 + ch * 8); vq = *(const v4u*)(Vg + (size_t)(rowbase + row) * 256 + kv * 64 + ch * 8); }
            *(LAS v4u*)(lds + AT_KS + row * 128 + ((ch ^ ((row >> 1) & 7)) << 4)) = kq;
            LAS unsigned short* vt = (LAS unsigned short*)(lds + AT_VT) + (ch * 8) * AT_VLD + row;
            vt[0 * AT_VLD] = (unsigned short)(vq.x & 0xffffu); vt[1 * AT_VLD] = (unsigned short)(vq.x >> 16);
            vt[2 * AT_VLD] = (unsigned short)(vq.y & 0xffffu); vt[3 * AT_VLD] = (unsigned short)(vq.y >> 16);
            vt[4 * AT_VLD] = (unsigned short)(vq.z & 0xffffu); vt[5 * AT_VLD] = (unsigned short)(vq.z >> 16);
            vt[6 * AT_VLD] = (unsigned short)(vq.w & 0xffffu); vt[7 * AT_VLD] = (unsigned short)(vq.w >> 16); }
        __syncthreads();
        const int g = wave >> 1, head = kv * 4 + g;
        const float snk = sink2[head];
        for (int sb = 0; sb < 2; ++sb) {
            const int qi = (wave & 1) * 2 + sb;
            const size_t rowq = (size_t)b * SEQ + n * 128 + qi * 32 + r32;
            bf16x8 qf[4];
#pragma unroll
            for (int kk = 0; kk < 4; ++kk) qf[kk] = *(const bf16x8*)(Q + rowq * D + head * HD + kk * 16 + hi * 8);
            f32x16 s[5];
#pragma unroll
            for (int t = 0; t < 5; ++t) { const int krow = (qi + t) * 32 + r32; const LAS unsigned char* kb = lds + AT_KS + krow * 128; const int sw = (krow >> 1) & 7;
                f32x16 a = {};
#pragma unroll
                for (int kk = 0; kk < 4; ++kk) { const bf16x8 kf = *(const LAS bf16x8*)(kb + (((2 * kk + hi) ^ sw) << 4)); a = __builtin_amdgcn_mfma_f32_32x32x16_bf16(kf, qf[kk], a, 0, 0, 0); }
                s[t] = a; }
            const int iq = qi * 32 + r32;
            float mx = snk;
#pragma unroll
            for (int t = 0; t < 5; ++t)
#pragma unroll
                for (int r = 0; r < 16; ++r) { const int sidx = (qi + t) * 32 + (r & 3) + 8 * (r >> 2) + 4 * hi; const int dist = iq + 128 - sidx;
                    const bool ok = (dist >= 0) && (dist < 128) && ((n > 0) || (sidx >= 128));
                    const float v = ok ? s[t][r] + bias2[head * 128 + (dist & 127)] : -INFINITY;
                    s[t][r] = v; mx = fmaxf(mx, v); }
            mx = fmaxf(mx, __shfl_xor(mx, 32));
            float l = 0.f;
#pragma unroll
            for (int t = 0; t < 5; ++t)
#pragma unroll
                for (int r = 0; r < 16; ++r) { const float p = __builtin_amdgcn_exp2f(s[t][r] - mx); s[t][r] = p; l += p; }
            l += __shfl_xor(l, 32);
            l += __builtin_amdgcn_exp2f(snk - mx);
            f32x16 o[2]; o[0] = (f32x16){}; o[1] = (f32x16){};
#pragma unroll
            for (int t = 0; t < 5; ++t)
#pragma unroll
                for (int ks = 0; ks < 2; ++ks) {
                    v4u pw; pw.x = pk2(s[t][8 * ks + 0], s[t][8 * ks + 1]); pw.y = pk2(s[t][8 * ks + 2], s[t][8 * ks + 3]); pw.z = pk2(s[t][8 * ks + 4], s[t][8 * ks + 5]); pw.w = pk2(s[t][8 * ks + 6], s[t][8 * ks + 7]);
                    const bf16x8 pb = __builtin_bit_cast(bf16x8, pw);
#pragma unroll
                    for (int db = 0; db < 2; ++db) { const LAS unsigned short* vp = (const LAS unsigned short*)(lds + AT_VT) + (db * 32 + r32) * AT_VLD + (qi + t) * 32 + 16 * ks + 4 * hi;
                        const s16x4 lo = *(const LAS s16x4*)vp, hh = *(const LAS s16x4*)(vp + 8);
                        const bf16x8 va = (bf16x8){lo[0], lo[1], lo[2], lo[3], hh[0], hh[1], hh[2], hh[3]};
                        o[db] = __builtin_amdgcn_mfma_f32_32x32x16_bf16(va, pb, o[db], 0, 0, 0); } }
            const float inv = 1.0f / l;
            bf16* orow = O + rowq * D + head * HD;
#pragma unroll
            for (int db = 0; db < 2; ++db)
#pragma unroll
                for (int gq = 0; gq < 4; ++gq) { v2u w; w.x = pk2(o[db][4 * gq + 0] * inv, o[db][4 * gq + 1] * inv); w.y = pk2(o[db][4 * gq + 2] * inv, o[db][4 * gq + 3] * inv);
                    *(v2u*)(orow + db * 32 + 8 * gq + 4 * hi) = w; }
        }
        __syncthreads();
    }
}

struct Args { const float* in[21]; float* out; unsigned char* ws; int ph_lo, ph_hi; };
static_assert(sizeof(Args) == 21 * 8 + 8 + 8 + 8, "Args has no padding");

__global__ void __launch_bounds__(NWAVES * 64, 2) mk_fwd(Args args) {
    extern __shared__ __attribute__((aligned(16))) unsigned char lds_raw[];
    Frame F;
    F.lds = (LAS unsigned char*)lds_raw;
    F.tid = threadIdx.x; F.lane = F.tid & 63; F.wave = __builtin_amdgcn_readfirstlane(F.tid >> 6);
    F.G = gridDim.x; { const int bx = blockIdx.x; F.vcu = (F.G % 8 == 0) ? (bx % 8) * (F.G / 8) + bx / 8 : bx; }
    unsigned char* ws = args.ws;
    const float* x = args.in[0];
    const float* mix_pre_g = args.in[1]; const float* mix_post_g = args.in[2]; const float* ffn_pre_g = args.in[3]; const float* ffn_post_g = args.in[4];
    float* out = args.out;
    bf16* XN = (bf16*)(ws + WS_XN); bf16* G0 = (bf16*)(ws + WS_G0); bf16* C0 = (bf16*)(ws + WS_C0); bf16* HF = (bf16*)(ws + WS_HF);
    bf16* Qb = (bf16*)(ws + WS_Q); bf16* Kb = (bf16*)(ws + WS_K); bf16* Vb = (bf16*)(ws + WS_V); bf16* Y = (bf16*)(ws + WS_Y); bf16* HB = (bf16*)(ws + WS_HB);
#if MK_COOP == 1
    cg::grid_group grid = cg::this_grid();
#elif MK_COOP == 2
    for (int u = F.tid; u < (LDS_BYTES - LDSCTL_OFF) / 4; u += NWAVES * 64) ((LAS unsigned*)(F.lds + LDSCTL_OFF))[u] = 0u;
    __syncthreads();
    XcdBarrier bar = xcd_barrier_post((unsigned*)(args.ws + WS_CTL) + CW_BAR, (volatile LAS unsigned*)(F.lds + MISC_OFF) + 8);
#endif
#ifndef PH_MASK
#define PH_MASK 0x7fff
#endif
#define PH_ON(k) ((PH_MASK >> (k)) & 1)
#ifndef REP_MASK
#define REP_MASK 0
#endif
    for (int ph2 = 2 * args.ph_lo; ph2 < 2 * args.ph_hi; ++ph2) {
        const int ph = ph2 >> 1;
        if ((ph2 & 1) && !((REP_MASK >> ph) & 1)) continue;
#if MK_COOP == 1
        if (ph2 != 2 * args.ph_lo) grid.sync();
#elif MK_COOP == 2
        if (ph2 != 2 * args.ph_lo) xcd_barrier(bar);
#endif
        { int t_ = threadIdx.x; asm volatile("" : "+v"(t_)); F.tid = t_; F.lane = t_ & 63; F.wave = __builtin_amdgcn_readfirstlane(t_ >> 6); }
        { long z_ = 0; asm volatile("" : "+s"(z_)); ws = args.ws + z_; out = args.out + z_; x = args.in[0] + z_; }
        XN = (bf16*)(ws + WS_XN); G0 = (bf16*)(ws + WS_G0); C0 = (bf16*)(ws + WS_C0); HF = (bf16*)(ws + WS_HF);
        Qb = (bf16*)(ws + WS_Q); Kb = (bf16*)(ws + WS_K); Vb = (bf16*)(ws + WS_V); Y = (bf16*)(ws + WS_Y); HB = (bf16*)(ws + WS_HB);
        if (ph == 0 && PH_ON(0)) {
            LAS float* scr = (LAS float*)(F.lds + F.wave * 16384);
            const int gw = F.vcu * NWAVES + F.wave, NGW = F.G * NWAVES;
            int it0 = 0;
#define P0_JOB(Wp, WTp, Kd, Nd, halfd) do { const float* W_ = (Wp); bf16* WT_ = (bf16*)(WTp); const int K_ = (Kd), N_ = (Nd), half_ = (halfd); const int nblk = N_ / 32, nitems = (K_ / 64) * nblk; \
                const int first = ((gw - it0) % NGW + NGW) % NGW; \
                for (int it = first; it < nitems; it += NGW) { const int kb = it / nblk, nb = it % nblk, n0 = 32 * nb; const int drow = half_ ? gate_row(n0, half_) : n0; \
                    p0_transpose_item(W_, K_, N_, WT_, 64 * kb, n0, drow, scr, F.lane); } \
                it0 += nitems; } while (0)
            P0_JOB(args.in[5], ws + WS_WIN, D, 2 * D, D);
            P0_JOB(args.in[11], ws + WS_WOUT, D, D, 0);
            P0_JOB(args.in[13], ws + WS_WQKV, D, NQKV, 0);
            P0_JOB(args.in[15], ws + WS_WO, D, D, 0);
            P0_JOB(args.in[19], ws + WS_WGU0, D, 2 * DFF, DFF);
            P0_JOB(args.in[19] + (size_t)D * 2 * DFF, ws + WS_WGU1, D, 2 * DFF, DFF);
            P0_JOB(args.in[20], ws + WS_WD0, DFF, D, 0);
            P0_JOB(args.in[20] + (size_t)DFF * D, ws + WS_WD1, DFF, D, 0);
#undef P0_JOB
            f32x4 g[4];
#pragma unroll
            for (int j = 0; j < 4; ++j) g[j] = ((const f32x4*)mix_pre_g)[F.lane + 64 * j];
            for (int m = gw; m < M; m += NGW) rms_row_to_bf16(x + (size_t)m * D, XN + (size_t)m * D, g, F.lane);
        } else if ((ph == 1 || ph == 5 || ph == 12) && PH_ON(1)) {
            if (ph == 1) { pg8::Gemm gm{XN, (const bf16*)(ws + WS_WIN), M, 2 * D, D}; pg8::StaticOrder S; S.init(M, 2 * D, F.G, (int)blockIdx.x);
                pg8::EpiGate<0> E{G0, D, args.in[6], D, 0};
                pg8::gemm_phase<pg8::EpiGate<0>, pg8::StaticOrder, PG8_ALIGN, PG8_SP2>(F.lds, gm, S, E, F.tid);
            } else { pg8::Gemm gm{XN, (const bf16*)(ws + (ph == 5 ? WS_WGU0 : WS_WGU1)), M, 2 * DFF, D}; pg8::StaticOrder S; S.init(M, 2 * DFF, F.G, (int)blockIdx.x);
                pg8::EpiGate<1> E{HF, DFF, nullptr, DFF, 1};
                pg8::gemm_phase<pg8::EpiGate<1>, pg8::StaticOrder, PG8_ALIGN, PG8_SP2>(F.lds, gm, S, E, F.tid); }
        } else if (ph == 2 && PH_ON(2)) {
            conv_phase(F, G0, C0, args.in[7], args.in[8], args.in[9], args.in[10]);
        } else if ((ph == 3 || ph == 6 || ph == 10 || ph == 13) && PH_ON(3)) {
            pg8::Gemm gm; const float* bias;
            if (ph == 3) { gm = pg8::Gemm{C0, (const bf16*)(ws + WS_WOUT), M, D, D}; bias = args.in[12]; }
            else if (ph == 10) { gm = pg8::Gemm{Qb, (const bf16*)(ws + WS_WO), M, D, D}; bias = args.in[16]; }
            else { gm = pg8::Gemm{HF, (const bf16*)(ws + (ph == 6 ? WS_WD0 : WS_WD1)), M, D, DFF, 1, 0}; bias = nullptr; }
            pg8::StaticOrder S; S.init(M, D, F.G, (int)blockIdx.x);
            pg8::EpiBf16 E{Y, D, bias};
            pg8::gemm_phase<pg8::EpiBf16, pg8::StaticOrder, PG8_ALIGN, PG8_SP2>(F.lds, gm, S, E, F.tid);
        } else if (ph == 4 && PH_ON(4)) { thin_phase<false, true>(F, Y, x, HB, XN, mix_post_g, ffn_pre_g);
        } else if (ph == 7 && PH_ON(4)) { thin_phase<true, true>(F, Y, HB, HB, XN, ffn_post_g, mix_pre_g + D);
        } else if (ph == 11 && PH_ON(4)) { thin_phase<true, true>(F, Y, HB, HB, XN, mix_post_g + D, ffn_pre_g + D);
        } else if (ph == 14 && PH_ON(4)) { thin_phase<true, false>(F, Y, HB, out, XN, ffn_post_g + D, nullptr);
        } else if (ph == 8 && PH_ON(8)) {
            pg8::Gemm gm{XN, (const bf16*)(ws + WS_WQKV), M, NQKV, D}; pg8::StaticOrder S; S.init(M, NQKV, F.G, (int)blockIdx.x);
            pg8::EpiQKV E{Qb, Kb, Vb, args.in[14], QSCALE};
            pg8::gemm_phase<pg8::EpiQKV, pg8::StaticOrder, PG8_ALIGN, PG8_SP2>(F.lds, gm, S, E, F.tid);
        } else if (ph == 9 && PH_ON(9)) {
            attn_phase(F, Qb, Kb, Vb, Qb, args.in[17], args.in[18]);
        }
    }
}

extern "C" void kernel_launch(void* const* d_in, const int* in_sizes, int n_in, void* d_out, int out_size, void* d_ws, size_t ws_size, hipStream_t stream) {
    static int grid = 0;
    if (grid == 0) {
        if (n_in != 21 || in_sizes[0] != M * D || out_size != M * D || ws_size < WS_END) { fprintf(stderr, "kernel_launch: unexpected shapes (n_in %d, in0 %d, out %d, ws %zu)\n", n_in, n_in > 0 ? in_sizes[0] : -1, out_size, ws_size); grid = -1; return; }
        int dev = 0, cus = 0, per_cu = 0;
        if (hipGetDevice(&dev) != hipSuccess || hipDeviceGetAttribute(&cus, hipDeviceAttributeMultiprocessorCount, dev) != hipSuccess) { grid = -1; return; }
        if (hipFuncSetAttribute((const void*)mk_fwd, hipFuncAttributeMaxDynamicSharedMemorySize, LDS_BYTES) != hipSuccess) { fprintf(stderr, "kernel_launch: hipFuncSetAttribute failed\n"); grid = -1; return; }
        if (hipOccupancyMaxActiveBlocksPerMultiprocessor(&per_cu, (const void*)mk_fwd, NWAVES * 64, LDS_BYTES) != hipSuccess || per_cu < 1) { fprintf(stderr, "kernel_launch: occupancy query says %d\n", per_cu); per_cu = 1; }
        (void)hipGetLastError();
        grid = cus * 1;
    }
    if (grid < 0) return;
    Args a{};
    for (int i = 0; i < 21; ++i) a.in[i] = (const float*)d_in[i];
    a.out = (float*)d_out; a.ws = (unsigned char*)d_ws;
#if MK_COOP == 2
    if (hipMemsetAsync((char*)d_ws + WS_CTL, 0, CTL_ZERO_BYTES, stream) != hipSuccess) { fprintf(stderr, "kernel_launch: hipMemsetAsync failed\n"); return; }
    a.ph_lo = 0; a.ph_hi = NPHASE;
    hipLaunchKernelGGL(mk_fwd, dim3(grid), dim3(NWAVES * 64), LDS_BYTES, stream, a);
#elif MK_COOP == 1
    a.ph_lo = 0; a.ph_hi = NPHASE;
    void* kargs[] = {&a};
    hipError_t e = hipLaunchCooperativeKernel((const void*)mk_fwd, dim3(grid), dim3(NWAVES * 64), kargs, LDS_BYTES, stream);
    if (e != hipSuccess) fprintf(stderr, "kernel_launch: cooperative launch failed: %s (grid %d)\n", hipGetErrorString(e), grid);
#else
    for (int ph = 0; ph < NPHASE; ++ph) { a.ph_lo = ph; a.ph_hi = ph + 1; hipLaunchKernelGGL(mk_fwd, dim3(grid), dim3(NWAVES * 64), LDS_BYTES, stream, a); }
#endif
}
```
